# Optimizing an MI355X kernel written in HIP

```python
import math
import jax, jax.numpy as jnp
from jax import lax
import numpy as np

D_MODEL = 1024
BATCH = 4
SEQ = 8192
DEPTH = 1

MOBA_HEADS = 8
MOBA_HEAD_DIM = 64
MOBA_BLOCK = 256
MOBA_TOPK = 3
MOBA_QCHUNK = 64
SWA_Q_HEADS = 8
SWA_KV_HEADS = 2
SWA_HEAD_DIM = 64
SWA_WINDOW = 128
SWA_BLOCK = 128
MEM_HEADS = 4
MEM_HEAD_DIM = 128
MEM_LEN = 256
NUM_BUCKETS = 32
MAX_EXACT = NUM_BUCKETS // 2
REL_MAX_DISTANCE = 128
N_SELF_HEADS = MOBA_HEADS + SWA_Q_HEADS
FFN_HIDDEN = 2816
CONV_WIDTH = 3
RMS_EPS = 1e-6
MOBA_W = MOBA_HEADS * MOBA_HEAD_DIM
SWA_QW = SWA_Q_HEADS * SWA_HEAD_DIM
SWA_KVW = SWA_KV_HEADS * SWA_HEAD_DIM
MEM_W = MEM_HEADS * MEM_HEAD_DIM
IN_SPLITS = (MOBA_W, MOBA_W, MOBA_W, SWA_QW, SWA_KVW, SWA_KVW, MEM_W, D_MODEL, D_MODEL, D_MODEL)
IN_WIDTH = 3 * MOBA_W + SWA_QW + 2 * SWA_KVW + MEM_W + 3 * D_MODEL

kernel_name = "hybrid_moba_swa_mem_convffn"


def rmsnorm(x, g):
    xf = x.astype(jnp.float32)
    r = lax.rsqrt(jnp.mean(xf * xf, axis=-1, keepdims=True) + RMS_EPS)
    return (xf * r * g.astype(jnp.float32)).astype(x.dtype)


def t5_bucket(dist):
    n = jnp.maximum(dist, 0)
    nf = jnp.maximum(n, 1).astype(jnp.float32)
    large = MAX_EXACT + (jnp.log(nf / MAX_EXACT) / math.log(REL_MAX_DISTANCE / MAX_EXACT)
                         * (NUM_BUCKETS - MAX_EXACT)).astype(jnp.int32)
    large = jnp.minimum(large, NUM_BUCKETS - 1)
    return jnp.where(n < MAX_EXACT, n, large)


def moba_attention(q, k, v, bias_table):
    B_, S_, H, dh = q.shape
    Sp = -(-S_ // MOBA_BLOCK) * MOBA_BLOCK
    pad = Sp - S_
    if pad:
        padw = ((0, 0), (0, pad), (0, 0), (0, 0))
        q, k, v = jnp.pad(q, padw), jnp.pad(k, padw), jnp.pad(v, padw)
    NB = Sp // MOBA_BLOCK
    scale = 1.0 / math.sqrt(dh)
    qh = q.transpose(0, 2, 1, 3)
    kb = k.reshape(B_, NB, MOBA_BLOCK, H, dh).transpose(0, 3, 1, 2, 4)
    vb = v.reshape(B_, NB, MOBA_BLOCK, H, dh).transpose(0, 3, 1, 2, 4)
    kmean = jnp.mean(kb.astype(jnp.float32), axis=3)
    gate = jnp.einsum('bhsd,bhnd->bhsn', qh.astype(jnp.float32), kmean)
    qblk = jnp.arange(Sp) // MOBA_BLOCK
    past = jnp.arange(NB)[None, :] < qblk[:, None]
    gate = jnp.where(past, gate, -jnp.inf)
    k_sel = min(MOBA_TOPK, NB)
    _, sel = lax.top_k(gate, k_sel)
    sel_valid = jnp.arange(k_sel)[None, :] < qblk[:, None]
    bi = jnp.arange(B_)[:, None, None, None]
    hi = jnp.arange(H)[None, :, None, None]
    hb = jnp.arange(H)[None, :, None, None, None]
    kpos_in = jnp.arange(MOBA_BLOCK)

    def chunk(i):
        q0 = i * MOBA_QCHUNK
        qc = lax.dynamic_slice_in_dim(qh, q0, MOBA_QCHUNK, axis=2)
        selc = lax.dynamic_slice_in_dim(sel, q0, MOBA_QCHUNK, axis=2)
        validc = lax.dynamic_slice_in_dim(sel_valid, q0, MOBA_QCHUNK, axis=0)
        c = q0 // MOBA_BLOCK
        kg = kb[bi, hi, selc]
        vg = vb[bi, hi, selc]
        k_own = lax.dynamic_index_in_dim(kb, c, axis=2, keepdims=False)
        v_own = lax.dynamic_index_in_dim(vb, c, axis=2, keepdims=False)
        qpos = q0 + jnp.arange(MOBA_QCHUNK)
        kpos_sel = selc[..., None] * MOBA_BLOCK + kpos_in
        s_sel = (jnp.einsum('bhqd,bhqnkd->bhqnk', qc, kg).astype(jnp.float32) * scale
                 + bias_table[hb, t5_bucket(qpos[:, None, None] - kpos_sel)].astype(jnp.float32))
        s_sel = jnp.where(validc[:, :, None], s_sel, -jnp.inf)
        dist_own = qpos[:, None] - (c * MOBA_BLOCK + kpos_in)[None, :]
        s_own = (jnp.einsum('bhqd,bhkd->bhqk', qc, k_own).astype(jnp.float32) * scale
                 + bias_table[:, t5_bucket(dist_own)].astype(jnp.float32))
        s_own = jnp.where(dist_own >= 0, s_own, -jnp.inf)
        s_all = jnp.concatenate(
            [s_sel.reshape(B_, H, MOBA_QCHUNK, k_sel * MOBA_BLOCK), s_own], axis=-1)
        p = jax.nn.softmax(s_all, axis=-1).astype(v.dtype)
        p_sel = p[..., :k_sel * MOBA_BLOCK].reshape(B_, H, MOBA_QCHUNK, k_sel, MOBA_BLOCK)
        p_own = p[..., k_sel * MOBA_BLOCK:]
        return (jnp.einsum('bhqnk,bhqnkd->bhqd', p_sel, vg)
                + jnp.einsum('bhqk,bhkd->bhqd', p_own, v_own))

    outs = lax.map(chunk, jnp.arange(Sp // MOBA_QCHUNK))
    out = outs.transpose(1, 0, 3, 2, 4).reshape(B_, Sp, H, dh)
    return out[:, :S_]


def swa_attention(q, k, v, sinks, bias_table):
    B_, S_, HQ, dh = q.shape
    HKV = k.shape[2]
    G = HQ // HKV
    QB = SWA_BLOCK
    nblk = S_ // QB
    scale = 1.0 / math.sqrt(dh)
    qb = q.reshape(B_, nblk, QB, HKV, G, dh)
    kb = k.reshape(B_, nblk, QB, HKV, dh)
    vb = v.reshape(B_, nblk, QB, HKV, dh)
    padw = ((0, 0), (1, 0), (0, 0), (0, 0), (0, 0))
    kband = jnp.concatenate([jnp.pad(kb, padw)[:, :-1], kb], axis=2)
    vband = jnp.concatenate([jnp.pad(vb, padw)[:, :-1], vb], axis=2)
    s = jnp.einsum('bnqhgd,bnkhd->bhgnqk', qb, kband).astype(jnp.float32) * scale
    dist = QB + jnp.arange(QB)[:, None] - jnp.arange(2 * QB)[None, :]
    bias = bias_table[:, t5_bucket(dist)].astype(jnp.float32).reshape(HKV, G, 1, QB, 2 * QB)
    s = s + bias
    kpos = (jnp.arange(nblk)[:, None] - 1) * QB + jnp.arange(2 * QB)[None, :]
    allowed = ((dist >= 0) & (dist < SWA_WINDOW))[None] & (kpos >= 0)[:, None, :]
    s = jnp.where(allowed, s, -jnp.inf)
    sink = sinks.astype(jnp.float32).reshape(HKV, G, 1, 1, 1)
    m = jnp.maximum(jnp.max(s, axis=-1, keepdims=True), sink)
    p = jnp.exp(s - m)
    denom = jnp.sum(p, axis=-1, keepdims=True) + jnp.exp(sink - m)
    p = (p / denom).astype(v.dtype)
    o = jnp.einsum('bhgnqk,bnkhd->bnqhgd', p, vband)
    return o.reshape(B_, S_, HQ * dh)


def memory_attention(q, km, vm):
    B_, S_, Hm, dm = q.shape
    s = jnp.einsum('bshd,bmhd->bhsm', q, km).astype(jnp.float32) * (1.0 / math.sqrt(dm))
    p = jax.nn.softmax(s, axis=-1).astype(vm.dtype)
    return jnp.einsum('bhsm,bmhd->bshd', p, vm).reshape(B_, S_, Hm * dm)


def causal_depthwise_conv(u, w, b):
    S_ = u.shape[1]
    up = jnp.pad(u, ((0, 0), (CONV_WIDTH - 1, 0), (0, 0)))
    out = b.astype(u.dtype)
    for t in range(CONV_WIDTH):
        out = out + w[t].astype(u.dtype) * up[:, t:t + S_]
    return out


def _normal(k, shape, scale):
    return jax.random.normal(k, shape, jnp.float32) * scale


def setup_inputs(seed: int = 0) -> dict:
    key = jax.random.key(seed)
    ks = jax.random.split(key, 20)
    L, D, F = DEPTH, D_MODEL, FFN_HIDDEN
    return {
        "x": _normal(ks[0], (BATCH, SEQ, D), 1.0),
        "mem": _normal(ks[1], (BATCH, MEM_LEN, D), 1.0),
        "norm_mix_pre": 1.0 + _normal(ks[2], (L, D), 0.05),
        "norm_mix_post": 1.0 + _normal(ks[3], (L, D), 0.05),
        "norm_ffn_pre": 1.0 + _normal(ks[4], (L, D), 0.05),
        "norm_ffn_post": 1.0 + _normal(ks[5], (L, D), 0.05),
        "norm_mem": 1.0 + _normal(ks[6], (L, D), 0.05),
        "w_in": _normal(ks[7], (L, D, IN_WIDTH), D ** -0.5),
        "rel_bias": _normal(ks[8], (NUM_BUCKETS, N_SELF_HEADS), 0.3),
        "swa_sinks": _normal(ks[9], (L, SWA_Q_HEADS), 1.0),
        "w_mem_kv": _normal(ks[10], (L, D, 2 * MEM_W), D ** -0.5),
        "w_branch_moba": _normal(ks[11], (L, MOBA_W, D), MOBA_W ** -0.5),
        "w_branch_swa": _normal(ks[12], (L, SWA_QW, D), SWA_QW ** -0.5),
        "w_branch_mem": _normal(ks[13], (L, MEM_W, D), MEM_W ** -0.5),
        "w_out": _normal(ks[14], (L, D, D), D ** -0.5),
        "w_ffn_up": _normal(ks[15], (L, D, 2 * F), D ** -0.5),
        "ffn_conv_w": _normal(ks[16], (L, CONV_WIDTH, 2 * F), CONV_WIDTH ** -0.5),
        "ffn_conv_b": _normal(ks[17], (L, 2 * F), 0.02),
        "w_ffn_down": _normal(ks[18], (L, F, D), F ** -0.5),
    }


def reference(x, mem, norm_mix_pre, norm_mix_post, norm_ffn_pre, norm_ffn_post, norm_mem,
              w_in, rel_bias, swa_sinks, w_mem_kv, w_branch_moba, w_branch_swa, w_branch_mem,
              w_out, w_ffn_up, ffn_conv_w, ffn_conv_b, w_ffn_down):
    B_, S_, _ = x.shape
    cuts = []
    acc = 0
    for width in IN_SPLITS[:-1]:
        acc += width
        cuts.append(acc)
    bias_moba = rel_bias[:, :MOBA_HEADS].T
    bias_swa = rel_bias[:, MOBA_HEADS:].T
    for l in range(DEPTH):
        h = rmsnorm(x, norm_mix_pre[l])
        proj = h @ w_in[l]
        (q_mb, k_mb, v_mb, q_sw, k_sw, v_sw, q_me,
         g_mb, g_sw, g_me) = jnp.split(proj, cuts, axis=-1)
        o_mb = moba_attention(
            q_mb.reshape(B_, S_, MOBA_HEADS, MOBA_HEAD_DIM),
            k_mb.reshape(B_, S_, MOBA_HEADS, MOBA_HEAD_DIM),
            v_mb.reshape(B_, S_, MOBA_HEADS, MOBA_HEAD_DIM), bias_moba).reshape(B_, S_, MOBA_W)
        o_sw = swa_attention(
            q_sw.reshape(B_, S_, SWA_Q_HEADS, SWA_HEAD_DIM),
            k_sw.reshape(B_, S_, SWA_KV_HEADS, SWA_HEAD_DIM),
            v_sw.reshape(B_, S_, SWA_KV_HEADS, SWA_HEAD_DIM), swa_sinks[l], bias_swa)
        kv_me = rmsnorm(mem, norm_mem[l]) @ w_mem_kv[l]
        M_ = mem.shape[1]
        k_me = kv_me[..., :MEM_W].reshape(B_, M_, MEM_HEADS, MEM_HEAD_DIM)
        v_me = kv_me[..., MEM_W:].reshape(B_, M_, MEM_HEADS, MEM_HEAD_DIM)
        o_me = memory_attention(q_me.reshape(B_, S_, MEM_HEADS, MEM_HEAD_DIM), k_me, v_me)
        merged = (jax.nn.sigmoid(g_mb) * (o_mb @ w_branch_moba[l])
                  + jax.nn.sigmoid(g_sw) * (o_sw @ w_branch_swa[l])
                  + jax.nn.sigmoid(g_me) * (o_me @ w_branch_mem[l]))
        x = x + rmsnorm(merged @ w_out[l], norm_mix_post[l])
        h = rmsnorm(x, norm_ffn_pre[l])
        u = causal_depthwise_conv(h @ w_ffn_up[l], ffn_conv_w[l], ffn_conv_b[l])
        u_gate, u_val = jnp.split(u, 2, axis=-1)
        y = (jax.nn.gelu(u_gate, approximate=True) * u_val) @ w_ffn_down[l]
        x = x + rmsnorm(y, norm_ffn_post[l])
    return x
```

```cpp
#include <hip/hip_runtime.h>
#include <cstdio>
#include <cstdint>

constexpr int BATCH = 4, SEQ = 8192, T = BATCH * SEQ, D = 1024;
constexpr int INW = 5888, FF = 2816, UPW = 2 * FF;
constexpr int C_QMB = 0, C_KMB = 512, C_VMB = 1024, C_QSW = 1536, C_KSW = 2048, C_VSW = 2176, C_QME = 2304, C_GMB = 2816, C_GSW = 3840, C_GME = 4864;
constexpr int MEMLEN = 256, MROWS = BATCH * MEMLEN;
constexpr int NBLK = 32, MBLK = 256;
constexpr float LOG2E = 1.4426950408889634f;
constexpr float C2_64 = 0.125f * LOG2E;
constexpr float C2_128 = 0.08838834764831845f * LOG2E;
constexpr float RMS_EPS = 1e-6f;

constexpr size_t MiB = 1u << 20;
constexpr size_t WS_CTL = 0, CTL_ZERO_BYTES = 1 * MiB;
constexpr size_t WS_KMEAN = 512 * 1024;
constexpr size_t WS_WIN = 1 * MiB, WS_WMEMKV = 13 * MiB, WS_WBR = 15 * MiB, WS_WOUT = 18 * MiB, WS_WUP = 20 * MiB, WS_WDOWN = 31 * MiB;
constexpr size_t WS_HM = 37 * MiB, WS_MEMKV = 39 * MiB, WS_TAB = 41 * MiB;
constexpr size_t WS_H = 44 * MiB;
constexpr size_t WS_PROJ = 108 * MiB;
constexpr size_t WS_Y1 = 108 * MiB, WS_ACT = 108 * MiB, WS_EDGE = 284 * MiB, WS_Y2 = 306 * MiB;
constexpr size_t WS_END = 512 * MiB;
typedef unsigned short bf16_t;
typedef short bf16x8 __attribute__((ext_vector_type(8)));
typedef float f32x4 __attribute__((ext_vector_type(4)));
typedef float f32x16 __attribute__((ext_vector_type(16)));
typedef unsigned u32x4 __attribute__((ext_vector_type(4)));

__device__ __forceinline__ unsigned f2bf(float f) { unsigned u = __builtin_bit_cast(unsigned, f); return (u + 0x7fffu + ((u >> 16) & 1u)) >> 16; }
__device__ __forceinline__ float bf2f(unsigned short b) { return __builtin_bit_cast(float, ((unsigned)b) << 16); }
__device__ __forceinline__ int crow(int r, int hi) { return (r & 3) + 8 * (r >> 2) + 4 * hi; }
__device__ __forceinline__ float wave_sum(float v) {
#pragma unroll
    for (int o = 1; o < 64; o <<= 1) v += __shfl_xor(v, o);
    return v;
}
__device__ __forceinline__ float wave_max(float v) {
#pragma unroll
    for (int o = 1; o < 64; o <<= 1) v = fmaxf(v, __shfl_xor(v, o));
    return v;
}
__device__ __forceinline__ int t5_bucket(int dist) {
    const int n = dist < 0 ? 0 : dist;
    if (n < 16) return n;
    int large = 16 + (int)(logf((float)n / 16.0f) / logf(8.0f) * 16.0f);
    return large < 31 ? large : 31;
}
__device__ __forceinline__ float gelu_tanh(float x) { const float u = 0.7978845608028654f * (x + 0.044715f * x * x * x); return 0.5f * x * (1.0f + tanhf(u)); }
__device__ __forceinline__ float sigmoidf_(float x) { return 1.0f / (1.0f + __expf(-x)); }

template <int MAP> __global__ void k_transpose(const float* __restrict__ W, int K, int N, bf16_t* __restrict__ WT, int ld, int coff) {
    __shared__ float tile[32][33];
    const int n0 = blockIdx.x * 32, k0 = blockIdx.y * 32, tx = threadIdx.x & 31, ty = threadIdx.x >> 5;
    for (int i = ty; i < 32; i += 8) tile[i][tx] = W[(size_t)(k0 + i) * N + n0 + tx];
    __syncthreads();
    for (int i = ty; i < 32; i += 8) { const int n = n0 + i; int row = n;
        if (MAP == 1) { const int isv = n >= FF, ch = isv ? n - FF : n; row = 256 * (ch >> 7) + 128 * isv + (ch & 127); }
        WT[(size_t)row * ld + coff + k0 + tx] = (bf16_t)f2bf(tile[tx][i]); }
}
__global__ void k_rmsnorm_bf16(const float* __restrict__ x, const float* __restrict__ g, bf16_t* __restrict__ out, int rows) {
    const int row = blockIdx.x * 4 + (threadIdx.x >> 6), lane = threadIdx.x & 63; if (row >= rows) return;
    const f32x4* xr = (const f32x4*)(x + (size_t)row * D) + lane; const f32x4* gr = (const f32x4*)g + lane;
    f32x4 v[4]; float s = 0.f;
#pragma unroll
    for (int j = 0; j < 4; ++j) { v[j] = xr[64 * j]; s += v[j].x * v[j].x + v[j].y * v[j].y + v[j].z * v[j].z + v[j].w * v[j].w; }
    const float r = rsqrtf(wave_sum(s) * (1.0f / D) + RMS_EPS);
#pragma unroll
    for (int j = 0; j < 4; ++j) { const f32x4 gg = gr[64 * j]; unsigned long long o = (unsigned long long)(f2bf(v[j].x * r * gg.x) | (f2bf(v[j].y * r * gg.y) << 16)) | ((unsigned long long)(f2bf(v[j].z * r * gg.z) | (f2bf(v[j].w * r * gg.w) << 16)) << 32);
        ((unsigned long long*)(out + (size_t)row * D))[lane + 64 * j] = o; }
}
__global__ void k_tables(const float* __restrict__ rel_bias, const float* __restrict__ conv_w, const float* __restrict__ conv_b, float* __restrict__ tab) {
    const int i = blockIdx.x * blockDim.x + threadIdx.x;
    if (i < 16 * 128) { const int h = i >> 7, d = i & 127; tab[i] = rel_bias[t5_bucket(d) * 16 + h] * LOG2E; }
    if (i < UPW) { const int isv = i >= FF, ch = isv ? i - FF : i, col = 256 * (ch >> 7) + 128 * isv + (ch & 127);
        float* cp = tab + 2048; cp[0 * UPW + col] = conv_w[0 * UPW + i]; cp[1 * UPW + col] = conv_w[1 * UPW + i]; cp[2 * UPW + col] = conv_w[2 * UPW + i]; cp[3 * UPW + col] = conv_b[i]; }
}

template <class Epi> __global__ void k_gemm_simple(const bf16_t* __restrict__ A, int lda, const bf16_t* __restrict__ Bt, int ldb, int M, int N, int K, Epi E) {
    const int lane = threadIdx.x & 63, w = threadIdx.x >> 6, r32 = lane & 31, hi = lane >> 5;
    const int tn = N / 32; const long tile = (long)blockIdx.x * 4 + w; if (tile >= (long)(M / 32) * tn) return;
    const int m0 = (int)(tile / tn) * 32, n0 = (int)(tile % tn) * 32;
    const bf16_t* ap = A + (size_t)(m0 + r32) * lda + 8 * hi; const bf16_t* bp = Bt + (size_t)(n0 + r32) * ldb + 8 * hi;
    f32x16 acc = {};
    for (int k = 0; k < K; k += 16) { const bf16x8 a = *(const bf16x8*)(ap + k), b = *(const bf16x8*)(bp + k); acc = __builtin_amdgcn_mfma_f32_32x32x16_bf16(a, b, acc, 0, 0, 0); }
#pragma unroll
    for (int r = 0; r < 16; ++r) E(m0 + crow(r, hi), n0 + r32, acc[r]);
}
struct EpiProj { bf16_t* P;
    __device__ void operator()(int row, int col, float v) const {
        float o = v;
        if (col < C_KMB) o = v * C2_64; else if (col >= C_QSW && col < C_KSW) o = v * C2_64; else if (col >= C_QME && col < C_GMB) o = v * C2_128; else if (col >= C_GMB) o = sigmoidf_(v);
        P[(size_t)row * INW + col] = (bf16_t)f2bf(o);
    } };
__global__ void k_kmean(const bf16_t* __restrict__ P, float* __restrict__ kmean) {
    const int i = blockIdx.x * blockDim.x + threadIdx.x; const int d = i & 63, n = (i >> 6) & 31, h = (i >> 11) & 7, b = i >> 14;
    const bf16_t* kp = P + (size_t)(b * SEQ + n * MBLK) * INW + C_KMB + h * 64 + d; float a = 0.f;
    for (int j = 0; j < MBLK; ++j) a += bf2f(kp[(size_t)j * INW]);
    kmean[i] = a * (1.0f / MBLK);
}
struct EpiBf { bf16_t* O; int ld; __device__ void operator()(int row, int col, float v) const { O[(size_t)row * ld + col] = (bf16_t)f2bf(v); } };
struct EpiF { float* O; int ld; __device__ void operator()(int row, int col, float v) const { O[(size_t)row * ld + col] = v; } };

__global__ void __launch_bounds__(256) k_moba_naive(const bf16_t* __restrict__ P, const float* __restrict__ kmean, const float* __restrict__ tab, bf16_t* __restrict__ OC) {
    __shared__ float ps[4][1024];
    const int w = threadIdx.x >> 6, lane = threadIdx.x & 63; const long id = (long)blockIdx.x * 4 + w; const int t = (int)(id >> 3), h = (int)(id & 7);
    const int b = t / SEQ, s = t % SEQ, c = s / MBLK;
    const bf16_t* qp = P + (size_t)t * INW + C_QMB + h * 64;
    float g = -INFINITY;
    if (lane < c) { const float* km = kmean + ((size_t)(b * 8 + h) * NBLK + lane) * 64; float a = 0.f; for (int d = 0; d < 64; ++d) a += bf2f(qp[d]) * km[d]; g = a; }
    int sel0, sel1, sel2; const int nsel = c < 3 ? c : 3;
    { float m = wave_max(g); unsigned long long bal = __ballot(g == m && g > -INFINITY); sel0 = bal ? __builtin_ctzll(bal) : -1; if (lane == sel0) g = -INFINITY;
      m = wave_max(g); bal = __ballot(g == m && g > -INFINITY); sel1 = bal ? __builtin_ctzll(bal) : -1; if (lane == sel1) g = -INFINITY;
      m = wave_max(g); bal = __ballot(g == m && g > -INFINITY); sel2 = bal ? __builtin_ctzll(bal) : -1; }
    float qv[64];
#pragma unroll
    for (int d = 0; d < 64; ++d) qv[d] = bf2f(qp[d]);
    const float* tb = tab + h * 128;
    float mx = -INFINITY;
    for (int seg = 0; seg < 4; ++seg) {
        const int blk = seg == 0 ? sel0 : seg == 1 ? sel1 : seg == 2 ? sel2 : c; const bool valid = seg < 3 ? (seg < nsel) : true;
        for (int j = lane; j < 256; j += 64) { float sc = -INFINITY;
            if (valid) { const int kpos = blk * MBLK + j, dist = s - kpos;
                if (dist >= 0) { const bf16_t* kp = P + (size_t)(b * SEQ + kpos) * INW + C_KMB + h * 64; float a = 0.f;
#pragma unroll
                    for (int d = 0; d < 64; ++d) a += qv[d] * bf2f(kp[d]);
                    sc = a + tb[dist < 127 ? dist : 127]; } }
            ps[w][seg * 256 + j] = sc; mx = fmaxf(mx, sc); } }
    mx = wave_max(mx); float l = 0.f;
    for (int j = lane; j < 1024; j += 64) { const float p = exp2f(ps[w][j] - mx); ps[w][j] = p; l += p; }
    l = wave_sum(l); __builtin_amdgcn_s_waitcnt(0); __builtin_amdgcn_wave_barrier();
    float o = 0.f;
    for (int seg = 0; seg < 4; ++seg) { const int blk = seg == 0 ? sel0 : seg == 1 ? sel1 : seg == 2 ? sel2 : c; if (seg < 3 && seg >= nsel) continue;
        const bf16_t* vp = P + (size_t)(b * SEQ + blk * MBLK) * INW + C_VMB + h * 64 + lane;
        for (int j = 0; j < 256; ++j) { const float p = ps[w][seg * 256 + j]; if (p != 0.f) o += p * bf2f(vp[(size_t)j * INW]); } }
    OC[(size_t)t * 1536 + h * 64 + lane] = (bf16_t)f2bf(o / l);
}
__global__ void __launch_bounds__(256) k_swa_naive(const bf16_t* __restrict__ P, const float* __restrict__ sinks, const float* __restrict__ tab, bf16_t* __restrict__ OC) {
    __shared__ float ps[4][128];
    const int w = threadIdx.x >> 6, lane = threadIdx.x & 63; const long id = (long)blockIdx.x * 4 + w; const int t = (int)(id >> 3), h = (int)(id & 7), kvh = h >> 2;
    const int b = t / SEQ, s = t % SEQ;
    const bf16_t* qp = P + (size_t)t * INW + C_QSW + h * 64; const float* tb = tab + (8 + h) * 128;
    float qv[64];
#pragma unroll
    for (int d = 0; d < 64; ++d) qv[d] = bf2f(qp[d]);
    const float sink = sinks[h] * LOG2E; float mx = sink;
    for (int j = lane; j < 128; j += 64) { const int kpos = s - j; float sc = -INFINITY;
        if (kpos >= 0) { const bf16_t* kp = P + (size_t)(b * SEQ + kpos) * INW + C_KSW + kvh * 64; float a = 0.f;
#pragma unroll
            for (int d = 0; d < 64; ++d) a += qv[d] * bf2f(kp[d]);
            sc = a + tb[j]; }
        ps[w][j] = sc; mx = fmaxf(mx, sc); }
    mx = wave_max(mx); float l = 0.f;
    for (int j = lane; j < 128; j += 64) { const float p = exp2f(ps[w][j] - mx); ps[w][j] = p; l += p; }
    l = wave_sum(l) + exp2f(sink - mx); __builtin_amdgcn_s_waitcnt(0); __builtin_amdgcn_wave_barrier();
    float o = 0.f;
    for (int j = 0; j < 128; ++j) { const int kpos = s - j; if (kpos < 0) break; o += ps[w][j] * bf2f(P[(size_t)(b * SEQ + kpos) * INW + C_VSW + kvh * 64 + lane]); }
    OC[(size_t)t * 1536 + 512 + h * 64 + lane] = (bf16_t)f2bf(o / l);
}
__global__ void k_mem_naive(const bf16_t* __restrict__ P, const bf16_t* __restrict__ KV, bf16_t* __restrict__ OC) {
    __shared__ float ps[4][256];
    const int w = threadIdx.x >> 6, lane = threadIdx.x & 63; const long id = (long)blockIdx.x * 4 + w; const int t = (int)(id >> 2), h = (int)(id & 3);
    const int b = t / SEQ;
    const bf16_t* qp = P + (size_t)t * INW + C_QME + h * 128;
    float mx = -INFINITY;
    for (int j = lane; j < 256; j += 64) { const bf16_t* kp = KV + (size_t)(b * MEMLEN + j) * 1024 + h * 128; float a = 0.f;
        for (int d = 0; d < 128; ++d) a += bf2f(qp[d]) * bf2f(kp[d]);
        ps[w][j] = a; mx = fmaxf(mx, a); }
    mx = wave_max(mx); float l = 0.f;
    for (int j = lane; j < 256; j += 64) { const float p = exp2f(ps[w][j] - mx); ps[w][j] = p; l += p; }
    l = wave_sum(l); __builtin_amdgcn_s_waitcnt(0); __builtin_amdgcn_wave_barrier();
    float o0 = 0.f, o1 = 0.f;
    for (int j = 0; j < 256; ++j) { const bf16_t* vp = KV + (size_t)(b * MEMLEN + j) * 1024 + 512 + h * 128; const float p = ps[w][j]; o0 += p * bf2f(vp[lane]); o1 += p * bf2f(vp[64 + lane]); }
    OC[(size_t)t * 1536 + 1024 + h * 128 + lane] = (bf16_t)f2bf(o0 / l); OC[(size_t)t * 1536 + 1024 + h * 128 + 64 + lane] = (bf16_t)f2bf(o1 / l);
}
__global__ void __launch_bounds__(256) k_branch_naive(const bf16_t* __restrict__ OC, const bf16_t* __restrict__ Wt, const bf16_t* __restrict__ P, bf16_t* __restrict__ MG) {
    const int lane = threadIdx.x & 63, w = threadIdx.x >> 6, r32 = lane & 31, hi = lane >> 5;
    const long tile = (long)blockIdx.x * 4 + w; const int m0 = (int)(tile / 32) * 32, n0 = (int)(tile % 32) * 32;
    f32x16 tot = {};
    for (int br = 0; br < 3; ++br) { f32x16 acc = {};
        const bf16_t* ap = OC + (size_t)(m0 + r32) * 1536 + 512 * br + 8 * hi; const bf16_t* bp = Wt + (size_t)(n0 + r32) * 1536 + 512 * br + 8 * hi;
        for (int k = 0; k < 512; k += 16) acc = __builtin_amdgcn_mfma_f32_32x32x16_bf16(*(const bf16x8*)(ap + k), *(const bf16x8*)(bp + k), acc, 0, 0, 0);
#pragma unroll
        for (int r = 0; r < 16; ++r) tot[r] += acc[r] * bf2f(P[(size_t)(m0 + crow(r, hi)) * INW + C_GMB + 1024 * br + n0 + r32]); }
#pragma unroll
    for (int r = 0; r < 16; ++r) MG[(size_t)(m0 + crow(r, hi)) * D + n0 + r32] = (bf16_t)f2bf(tot[r]);
}
__global__ void k_norm2(const float* __restrict__ x, const float* __restrict__ Y1, const float* __restrict__ g1, const float* __restrict__ g2, float* __restrict__ X1, bf16_t* __restrict__ H2) {
    const int row = blockIdx.x * 4 + (threadIdx.x >> 6), lane = threadIdx.x & 63;
    const f32x4* yr = (const f32x4*)(Y1 + (size_t)row * D) + lane; const f32x4* xr = (const f32x4*)(x + (size_t)row * D) + lane;
    f32x4 v[4]; float s = 0.f;
#pragma unroll
    for (int j = 0; j < 4; ++j) { v[j] = yr[64 * j]; s += v[j].x * v[j].x + v[j].y * v[j].y + v[j].z * v[j].z + v[j].w * v[j].w; }
    const float r = rsqrtf(wave_sum(s) * (1.0f / D) + RMS_EPS); float s2 = 0.f;
#pragma unroll
    for (int j = 0; j < 4; ++j) { const f32x4 gg = ((const f32x4*)g1)[lane + 64 * j]; v[j] = xr[64 * j] + v[j] * r * gg; s2 += v[j].x * v[j].x + v[j].y * v[j].y + v[j].z * v[j].z + v[j].w * v[j].w;
        ((f32x4*)(X1 + (size_t)row * D))[lane + 64 * j] = v[j]; }
    const float r2 = rsqrtf(wave_sum(s2) * (1.0f / D) + RMS_EPS);
#pragma unroll
    for (int j = 0; j < 4; ++j) { const f32x4 gg = ((const f32x4*)g2)[lane + 64 * j]; unsigned long long o = (unsigned long long)(f2bf(v[j].x * r2 * gg.x) | (f2bf(v[j].y * r2 * gg.y) << 16)) | ((unsigned long long)(f2bf(v[j].z * r2 * gg.z) | (f2bf(v[j].w * r2 * gg.w) << 16)) << 32);
        ((unsigned long long*)(H2 + (size_t)row * D))[lane + 64 * j] = o; }
}
__global__ void k_final(const float* __restrict__ Y2, const float* __restrict__ g, float* __restrict__ out) {
    const int row = blockIdx.x * 4 + (threadIdx.x >> 6), lane = threadIdx.x & 63;
    const f32x4* yr = (const f32x4*)(Y2 + (size_t)row * D) + lane; f32x4* xr = (f32x4*)(out + (size_t)row * D) + lane;
    f32x4 v[4]; float s = 0.f;
#pragma unroll
    for (int j = 0; j < 4; ++j) { v[j] = yr[64 * j]; s += v[j].x * v[j].x + v[j].y * v[j].y + v[j].z * v[j].z + v[j].w * v[j].w; }
    const float r = rsqrtf(wave_sum(s) * (1.0f / D) + RMS_EPS);
#pragma unroll
    for (int j = 0; j < 4; ++j) { const f32x4 gg = ((const f32x4*)g)[lane + 64 * j]; xr[64 * j] = xr[64 * j] + v[j] * r * gg; }
}
__global__ void __launch_bounds__(256) k_up_naive(const bf16_t* __restrict__ H2, const bf16_t* __restrict__ Wt, const float* __restrict__ convp, bf16_t* __restrict__ ACT) {
    const int lane = threadIdx.x & 63, w = threadIdx.x >> 6, r32 = lane & 31, hi = lane >> 5;
    const long tile = (long)blockIdx.x * 4 + w; const int m0 = (int)(tile / (FF / 32)) * 32, c0 = (int)(tile % (FF / 32)) * 32;
    const int grow = 256 * (c0 >> 7) + (c0 & 127);
    f32x16 ag[3] = {}, av[3] = {};
    const int trow = m0 + r32, spos = trow % SEQ;
    const bf16_t* bg = Wt + (size_t)(grow + r32) * D + 8 * hi; const bf16_t* bv = bg + (size_t)128 * D;
    for (int k = 0; k < D; k += 16) { const bf16x8 g = *(const bf16x8*)(bg + k), v = *(const bf16x8*)(bv + k);
#pragma unroll
        for (int s = 0; s < 3; ++s) { bf16x8 a = {}; if (spos - s >= 0) a = *(const bf16x8*)(H2 + (size_t)(trow - s) * D + 8 * hi + k);
            ag[s] = __builtin_amdgcn_mfma_f32_32x32x16_bf16(a, g, ag[s], 0, 0, 0); av[s] = __builtin_amdgcn_mfma_f32_32x32x16_bf16(a, v, av[s], 0, 0, 0); } }
    const int colg = grow + r32, colv = colg + 128;
    const float wg0 = convp[colg], wg1 = convp[UPW + colg], wg2 = convp[2 * UPW + colg], bgc = convp[3 * UPW + colg];
    const float wv0 = convp[colv], wv1 = convp[UPW + colv], wv2 = convp[2 * UPW + colv], bvc = convp[3 * UPW + colv];
#pragma unroll
    for (int r = 0; r < 16; ++r) { const float ug = bgc + wg2 * ag[0][r] + wg1 * ag[1][r] + wg0 * ag[2][r], uv = bvc + wv2 * av[0][r] + wv1 * av[1][r] + wv0 * av[2][r];
        ACT[(size_t)(m0 + crow(r, hi)) * FF + c0 + r32] = (bf16_t)f2bf(gelu_tanh(ug) * uv); }
}

extern "C" void kernel_launch(void* const* d_in, const int* in_sizes, int n_in, void* d_out, int out_size, void* d_ws, size_t ws_size, hipStream_t stream) {
    if (n_in != 19 || in_sizes[0] != T * D || out_size != T * D || ws_size < WS_END) { fprintf(stderr, "kernel_launch: unexpected shapes / workspace (n_in %d, ws %zu)\n", n_in, ws_size); return; }
    const float* x = (const float*)d_in[0]; const float* mem = (const float*)d_in[1];
    const float *g_mix_pre = (const float*)d_in[2], *g_mix_post = (const float*)d_in[3], *g_ffn_pre = (const float*)d_in[4], *g_ffn_post = (const float*)d_in[5], *g_mem = (const float*)d_in[6];
    const float *w_in = (const float*)d_in[7], *rel_bias = (const float*)d_in[8], *sinks = (const float*)d_in[9], *w_mem_kv = (const float*)d_in[10];
    const float *w_br_mb = (const float*)d_in[11], *w_br_sw = (const float*)d_in[12], *w_br_me = (const float*)d_in[13], *w_out = (const float*)d_in[14], *w_up = (const float*)d_in[15];
    const float *conv_w = (const float*)d_in[16], *conv_b = (const float*)d_in[17], *w_down = (const float*)d_in[18];
    unsigned char* ws = (unsigned char*)d_ws; float* out = (float*)d_out;
    bf16_t *Win_t = (bf16_t*)(ws + WS_WIN), *Wmkv_t = (bf16_t*)(ws + WS_WMEMKV), *Wbr_t = (bf16_t*)(ws + WS_WBR), *Wout_t = (bf16_t*)(ws + WS_WOUT), *Wup_t = (bf16_t*)(ws + WS_WUP), *Wdown_t = (bf16_t*)(ws + WS_WDOWN);
    bf16_t *HM = (bf16_t*)(ws + WS_HM), *MEMKV = (bf16_t*)(ws + WS_MEMKV), *H = (bf16_t*)(ws + WS_H), *PROJ = (bf16_t*)(ws + WS_PROJ), *OCAT = (bf16_t*)d_out, *MERGED = (bf16_t*)(ws + WS_H), *H2 = (bf16_t*)(ws + WS_H), *ACT = (bf16_t*)(ws + WS_ACT);
    float *tab = (float*)(ws + WS_TAB), *kmean = (float*)(ws + WS_KMEAN), *Y1 = (float*)(ws + WS_Y1), *Y2 = (float*)(ws + WS_Y2), *X1 = out;
    (void)hipMemsetAsync(ws + WS_CTL, 0, CTL_ZERO_BYTES, stream);
    k_transpose<0><<<dim3(INW / 32, D / 32), 256, 0, stream>>>(w_in, D, INW, Win_t, D, 0);
    k_transpose<0><<<dim3(1024 / 32, D / 32), 256, 0, stream>>>(w_mem_kv, D, 1024, Wmkv_t, D, 0);
    k_transpose<0><<<dim3(D / 32, 512 / 32), 256, 0, stream>>>(w_br_mb, 512, D, Wbr_t, 1536, 0);
    k_transpose<0><<<dim3(D / 32, 512 / 32), 256, 0, stream>>>(w_br_sw, 512, D, Wbr_t, 1536, 512);
    k_transpose<0><<<dim3(D / 32, 512 / 32), 256, 0, stream>>>(w_br_me, 512, D, Wbr_t, 1536, 1024);
    k_transpose<0><<<dim3(D / 32, D / 32), 256, 0, stream>>>(w_out, D, D, Wout_t, D, 0);
    k_transpose<1><<<dim3(UPW / 32, D / 32), 256, 0, stream>>>(w_up, D, UPW, Wup_t, D, 0);
    k_transpose<0><<<dim3(D / 32, FF / 32), 256, 0, stream>>>(w_down, FF, D, Wdown_t, FF, 0);
    k_tables<<<(UPW + 255) / 256, 256, 0, stream>>>(rel_bias, conv_w, conv_b, tab);
    k_rmsnorm_bf16<<<T / 4, 256, 0, stream>>>(x, g_mix_pre, H, T);
    k_rmsnorm_bf16<<<MROWS / 4, 256, 0, stream>>>(mem, g_mem, HM, MROWS);
    k_gemm_simple<EpiProj><<<(T / 32) * (INW / 32) / 4, 256, 0, stream>>>(H, D, Win_t, D, T, INW, D, EpiProj{PROJ});
    k_kmean<<<BATCH * 8 * NBLK * 64 / 256, 256, 0, stream>>>(PROJ, kmean);
    k_gemm_simple<EpiBf><<<(MROWS / 32) * (1024 / 32) / 4, 256, 0, stream>>>(HM, D, Wmkv_t, D, MROWS, 1024, D, EpiBf{MEMKV, 1024});
    k_moba_naive<<<T * 8 / 4, 256, 0, stream>>>(PROJ, kmean, tab, OCAT);
    k_swa_naive<<<T * 8 / 4, 256, 0, stream>>>(PROJ, sinks, tab, OCAT);
    k_mem_naive<<<T * 4 / 4, 256, 0, stream>>>(PROJ, MEMKV, OCAT);
    k_branch_naive<<<(T / 32) * (D / 32) / 4, 256, 0, stream>>>(OCAT, Wbr_t, PROJ, MERGED);
    k_gemm_simple<EpiF><<<(T / 32) * (D / 32) / 4, 256, 0, stream>>>(MERGED, D, Wout_t, D, T, D, D, EpiF{Y1, D});
    k_norm2<<<T / 4, 256, 0, stream>>>(x, Y1, g_mix_post, g_ffn_pre, X1, H2);
    k_up_naive<<<(T / 32) * (FF / 32) / 4, 256, 0, stream>>>(H2, Wup_t, tab + 2048, ACT);
    k_gemm_simple<EpiF><<<(T / 32) * (D / 32) / 4, 256, 0, stream>>>(ACT, FF, Wdown_t, FF, T, D, FF, EpiF{Y2, D});
    k_final<<<T / 4, 256, 0, stream>>>(Y2, g_ffn_post, out);
}
```

```cpp
#include <hip/hip_runtime.h>
#include <cstdio>
#include <cstdint>

constexpr int BATCH = 4, SEQ = 8192, T = BATCH * SEQ, D = 1024;
constexpr int INW = 5888, FF = 2816, UPW = 2 * FF;
constexpr int C_QMB = 0, C_KMB = 512, C_VMB = 1024, C_QSW = 1536, C_KSW = 2048, C_VSW = 2176, C_QME = 2304, C_GMB = 2816, C_GSW = 3840, C_GME = 4864;
constexpr int MEMLEN = 256, MROWS = BATCH * MEMLEN;
constexpr int NBLK = 32, MBLK = 256;
constexpr float LOG2E = 1.4426950408889634f;
constexpr float C2_64 = 0.125f * LOG2E;
constexpr float C2_128 = 0.08838834764831845f * LOG2E;
constexpr float RMS_EPS = 1e-6f;

constexpr size_t MiB = 1u << 20;
constexpr size_t WS_CTL = 0, CTL_ZERO_BYTES = 1 * MiB;
constexpr size_t WS_KMEAN = 512 * 1024;
constexpr size_t WS_WIN = 1 * MiB, WS_WMEMKV = 13 * MiB, WS_WBR = 15 * MiB, WS_WOUT = 18 * MiB, WS_WUP = 20 * MiB, WS_WDOWN = 31 * MiB;
constexpr size_t WS_HM = 37 * MiB, WS_MEMKV = 39 * MiB, WS_TAB = 41 * MiB;
constexpr size_t WS_H = 44 * MiB;
constexpr size_t WS_PROJ = 108 * MiB;
constexpr size_t WS_Y1 = 108 * MiB, WS_ACT = 108 * MiB, WS_EDGE = 284 * MiB, WS_Y2 = 306 * MiB;
constexpr size_t WS_END = 512 * MiB;
typedef unsigned short bf16_t;
typedef short bf16x8 __attribute__((ext_vector_type(8)));
typedef float f32x4 __attribute__((ext_vector_type(4)));
typedef float f32x16 __attribute__((ext_vector_type(16)));
typedef unsigned u32x4 __attribute__((ext_vector_type(4)));

__device__ __forceinline__ unsigned f2bf(float f) { unsigned u = __builtin_bit_cast(unsigned, f); return (u + 0x7fffu + ((u >> 16) & 1u)) >> 16; }
__device__ __forceinline__ float bf2f(unsigned short b) { return __builtin_bit_cast(float, ((unsigned)b) << 16); }
__device__ __forceinline__ int crow(int r, int hi) { return (r & 3) + 8 * (r >> 2) + 4 * hi; }
__device__ __forceinline__ float wave_sum(float v) {
#pragma unroll
    for (int o = 1; o < 64; o <<= 1) v += __shfl_xor(v, o);
    return v;
}
__device__ __forceinline__ float wave_max(float v) {
#pragma unroll
    for (int o = 1; o < 64; o <<= 1) v = fmaxf(v, __shfl_xor(v, o));
    return v;
}
__device__ __forceinline__ int t5_bucket(int dist) {
    const int n = dist < 0 ? 0 : dist;
    if (n < 16) return n;
    int large = 16 + (int)(logf((float)n / 16.0f) / logf(8.0f) * 16.0f);
    return large < 31 ? large : 31;
}
__device__ __forceinline__ float gelu_tanh(float x) { const float u = 0.7978845608028654f * (x + 0.044715f * x * x * x); return 0.5f * x * (1.0f + tanhf(u)); }
__device__ __forceinline__ float sigmoidf_(float x) { return 1.0f / (1.0f + __expf(-x)); }

template <int MAP> __global__ void k_transpose(const float* __restrict__ W, int K, int N, bf16_t* __restrict__ WT, int ld, int coff) {
    __shared__ float tile[32][33];
    const int n0 = blockIdx.x * 32, k0 = blockIdx.y * 32, tx = threadIdx.x & 31, ty = threadIdx.x >> 5;
    for (int i = ty; i < 32; i += 8) tile[i][tx] = W[(size_t)(k0 + i) * N + n0 + tx];
    __syncthreads();
    for (int i = ty; i < 32; i += 8) { const int n = n0 + i; int row = n;
        if (MAP == 1) { const int isv = n >= FF, ch = isv ? n - FF : n; row = 256 * (ch >> 7) + 128 * isv + (ch & 127); }
        WT[(size_t)row * ld + coff + k0 + tx] = (bf16_t)f2bf(tile[tx][i]); }
}
__global__ void k_rmsnorm_bf16(const float* __restrict__ x, const float* __restrict__ g, bf16_t* __restrict__ out, int rows) {
    const int row = blockIdx.x * 4 + (threadIdx.x >> 6), lane = threadIdx.x & 63; if (row >= rows) return;
    const f32x4* xr = (const f32x4*)(x + (size_t)row * D) + lane; const f32x4* gr = (const f32x4*)g + lane;
    f32x4 v[4]; float s = 0.f;
#pragma unroll
    for (int j = 0; j < 4; ++j) { v[j] = xr[64 * j]; s += v[j].x * v[j].x + v[j].y * v[j].y + v[j].z * v[j].z + v[j].w * v[j].w; }
    const float r = rsqrtf(wave_sum(s) * (1.0f / D) + RMS_EPS);
#pragma unroll
    for (int j = 0; j < 4; ++j) { const f32x4 gg = gr[64 * j]; unsigned long long o = (unsigned long long)(f2bf(v[j].x * r * gg.x) | (f2bf(v[j].y * r * gg.y) << 16)) | ((unsigned long long)(f2bf(v[j].z * r * gg.z) | (f2bf(v[j].w * r * gg.w) << 16)) << 32);
        ((unsigned long long*)(out + (size_t)row * D))[lane + 64 * j] = o; }
}
__global__ void k_tables(const float* __restrict__ rel_bias, const float* __restrict__ conv_w, const float* __restrict__ conv_b, float* __restrict__ tab) {
    const int i = blockIdx.x * blockDim.x + threadIdx.x;
    if (i < 16 * 128) { const int h = i >> 7, d = i & 127; tab[i] = rel_bias[t5_bucket(d) * 16 + h] * LOG2E; }
    if (i < UPW) { const int isv = i >= FF, ch = isv ? i - FF : i, col = 256 * (ch >> 7) + 128 * isv + (ch & 127);
        float* cp = tab + 2048; cp[0 * UPW + col] = conv_w[0 * UPW + i]; cp[1 * UPW + col] = conv_w[1 * UPW + i]; cp[2 * UPW + col] = conv_w[2 * UPW + i]; cp[3 * UPW + col] = conv_b[i]; }
}

template <class Epi> __global__ void k_gemm_simple(const bf16_t* __restrict__ A, int lda, const bf16_t* __restrict__ Bt, int ldb, int M, int N, int K, Epi E) {
    const int lane = threadIdx.x & 63, w = threadIdx.x >> 6, r32 = lane & 31, hi = lane >> 5;
    const int tn = N / 32; const long tile = (long)blockIdx.x * 4 + w; if (tile >= (long)(M / 32) * tn) return;
    const int m0 = (int)(tile / tn) * 32, n0 = (int)(tile % tn) * 32;
    const bf16_t* ap = A + (size_t)(m0 + r32) * lda + 8 * hi; const bf16_t* bp = Bt + (size_t)(n0 + r32) * ldb + 8 * hi;
    f32x16 acc = {};
    for (int k = 0; k < K; k += 16) { const bf16x8 a = *(const bf16x8*)(ap + k), b = *(const bf16x8*)(bp + k); acc = __builtin_amdgcn_mfma_f32_32x32x16_bf16(a, b, acc, 0, 0, 0); }
#pragma unroll
    for (int r = 0; r < 16; ++r) E(m0 + crow(r, hi), n0 + r32, acc[r]);
}
struct EpiProj { bf16_t* P;
    __device__ void operator()(int row, int col, float v) const {
        float o = v;
        if (col < C_KMB) o = v * C2_64; else if (col >= C_QSW && col < C_KSW) o = v * C2_64; else if (col >= C_QME && col < C_GMB) o = v * C2_128; else if (col >= C_GMB) o = sigmoidf_(v);
        P[(size_t)row * INW + col] = (bf16_t)f2bf(o);
    } };
__global__ void k_kmean(const bf16_t* __restrict__ P, float* __restrict__ kmean) {
    const int i = blockIdx.x * blockDim.x + threadIdx.x; const int d = i & 63, n = (i >> 6) & 31, h = (i >> 11) & 7, b = i >> 14;
    const bf16_t* kp = P + (size_t)(b * SEQ + n * MBLK) * INW + C_KMB + h * 64 + d; float a = 0.f;
    for (int j = 0; j < MBLK; ++j) a += bf2f(kp[(size_t)j * INW]);
    kmean[i] = a * (1.0f / MBLK);
}
struct EpiBf { bf16_t* O; int ld; __device__ void operator()(int row, int col, float v) const { O[(size_t)row * ld + col] = (bf16_t)f2bf(v); } };
struct EpiF { float* O; int ld; __device__ void operator()(int row, int col, float v) const { O[(size_t)row * ld + col] = v; } };

__global__ void __launch_bounds__(256) k_moba_naive(const bf16_t* __restrict__ P, const float* __restrict__ kmean, const float* __restrict__ tab, bf16_t* __restrict__ OC) {
    __shared__ float ps[4][1024];
    const int w = threadIdx.x >> 6, lane = threadIdx.x & 63; const long id = (long)blockIdx.x * 4 + w; const int t = (int)(id >> 3), h = (int)(id & 7);
    const int b = t / SEQ, s = t % SEQ, c = s / MBLK;
    const bf16_t* qp = P + (size_t)t * INW + C_QMB + h * 64;
    float g = -INFINITY;
    if (lane < c) { const float* km = kmean + ((size_t)(b * 8 + h) * NBLK + lane) * 64; float a = 0.f; for (int d = 0; d < 64; ++d) a += bf2f(qp[d]) * km[d]; g = a; }
    int sel0, sel1, sel2; const int nsel = c < 3 ? c : 3;
    { float m = wave_max(g); unsigned long long bal = __ballot(g == m && g > -INFINITY); sel0 = bal ? __builtin_ctzll(bal) : -1; if (lane == sel0) g = -INFINITY;
      m = wave_max(g); bal = __ballot(g == m && g > -INFINITY); sel1 = bal ? __builtin_ctzll(bal) : -1; if (lane == sel1) g = -INFINITY;
      m = wave_max(g); bal = __ballot(g == m && g > -INFINITY); sel2 = bal ? __builtin_ctzll(bal) : -1; }
    float qv[64];
#pragma unroll
    for (int d = 0; d < 64; ++d) qv[d] = bf2f(qp[d]);
    const float* tb = tab + h * 128;
    float mx = -INFINITY;
    for (int seg = 0; seg < 4; ++seg) {
        const int blk = seg == 0 ? sel0 : seg == 1 ? sel1 : seg == 2 ? sel2 : c; const bool valid = seg < 3 ? (seg < nsel) : true;
        for (int j = lane; j < 256; j += 64) { float sc = -INFINITY;
            if (valid) { const int kpos = blk * MBLK + j, dist = s - kpos;
                if (dist >= 0) { const bf16_t* kp = P + (size_t)(b * SEQ + kpos) * INW + C_KMB + h * 64; float a = 0.f;
#pragma unroll
                    for (int d = 0; d < 64; ++d) a += qv[d] * bf2f(kp[d]);
                    sc = a + tb[dist < 127 ? dist : 127]; } }
            ps[w][seg * 256 + j] = sc; mx = fmaxf(mx, sc); } }
    mx = wave_max(mx); float l = 0.f;
    for (int j = lane; j < 1024; j += 64) { const float p = exp2f(ps[w][j] - mx); ps[w][j] = p; l += p; }
    l = wave_sum(l); __builtin_amdgcn_s_waitcnt(0); __builtin_amdgcn_wave_barrier();
    float o = 0.f;
    for (int seg = 0; seg < 4; ++seg) { const int blk = seg == 0 ? sel0 : seg == 1 ? sel1 : seg == 2 ? sel2 : c; if (seg < 3 && seg >= nsel) continue;
        const bf16_t* vp = P + (size_t)(b * SEQ + blk * MBLK) * INW + C_VMB + h * 64 + lane;
        for (int j = 0; j < 256; ++j) { const float p = ps[w][seg * 256 + j]; if (p != 0.f) o += p * bf2f(vp[(size_t)j * INW]); } }
    OC[(size_t)t * 1536 + h * 64 + lane] = (bf16_t)f2bf(o / l);
}
__global__ void __launch_bounds__(256) k_swa_naive(const bf16_t* __restrict__ P, const float* __restrict__ sinks, const float* __restrict__ tab, bf16_t* __restrict__ OC) {
    __shared__ float ps[4][128];
    const int w = threadIdx.x >> 6, lane = threadIdx.x & 63; const long id = (long)blockIdx.x * 4 + w; const int t = (int)(id >> 3), h = (int)(id & 7), kvh = h >> 2;
    const int b = t / SEQ, s = t % SEQ;
    const bf16_t* qp = P + (size_t)t * INW + C_QSW + h * 64; const float* tb = tab + (8 + h) * 128;
    float qv[64];
#pragma unroll
    for (int d = 0; d < 64; ++d) qv[d] = bf2f(qp[d]);
    const float sink = sinks[h] * LOG2E; float mx = sink;
    for (int j = lane; j < 128; j += 64) { const int kpos = s - j; float sc = -INFINITY;
        if (kpos >= 0) { const bf16_t* kp = P + (size_t)(b * SEQ + kpos) * INW + C_KSW + kvh * 64; float a = 0.f;
#pragma unroll
            for (int d = 0; d < 64; ++d) a += qv[d] * bf2f(kp[d]);
            sc = a + tb[j]; }
        ps[w][j] = sc; mx = fmaxf(mx, sc); }
    mx = wave_max(mx); float l = 0.f;
    for (int j = lane; j < 128; j += 64) { const float p = exp2f(ps[w][j] - mx); ps[w][j] = p; l += p; }
    l = wave_sum(l) + exp2f(sink - mx); __builtin_amdgcn_s_waitcnt(0); __builtin_amdgcn_wave_barrier();
    float o = 0.f;
    for (int j = 0; j < 128; ++j) { const int kpos = s - j; if (kpos < 0) break; o += ps[w][j] * bf2f(P[(size_t)(b * SEQ + kpos) * INW + C_VSW + kvh * 64 + lane]); }
    OC[(size_t)t * 1536 + 512 + h * 64 + lane] = (bf16_t)f2bf(o / l);
}
__global__ void k_mem_naive(const bf16_t* __restrict__ P, const bf16_t* __restrict__ KV, bf16_t* __restrict__ OC) {
    __shared__ float ps[4][256];
    const int w = threadIdx.x >> 6, lane = threadIdx.x & 63; const long id = (long)blockIdx.x * 4 + w; const int t = (int)(id >> 2), h = (int)(id & 3);
    const int b = t / SEQ;
    const bf16_t* qp = P + (size_t)t * INW + C_QME + h * 128;
    float mx = -INFINITY;
    for (int j = lane; j < 256; j += 64) { const bf16_t* kp = KV + (size_t)(b * MEMLEN + j) * 1024 + h * 128; float a = 0.f;
        for (int d = 0; d < 128; ++d) a += bf2f(qp[d]) * bf2f(kp[d]);
        ps[w][j] = a; mx = fmaxf(mx, a); }
    mx = wave_max(mx); float l = 0.f;
    for (int j = lane; j < 256; j += 64) { const float p = exp2f(ps[w][j] - mx); ps[w][j] = p; l += p; }
    l = wave_sum(l); __builtin_amdgcn_s_waitcnt(0); __builtin_amdgcn_wave_barrier();
    float o0 = 0.f, o1 = 0.f;
    for (int j = 0; j < 256; ++j) { const bf16_t* vp = KV + (size_t)(b * MEMLEN + j) * 1024 + 512 + h * 128; const float p = ps[w][j]; o0 += p * bf2f(vp[lane]); o1 += p * bf2f(vp[64 + lane]); }
    OC[(size_t)t * 1536 + 1024 + h * 128 + lane] = (bf16_t)f2bf(o0 / l); OC[(size_t)t * 1536 + 1024 + h * 128 + 64 + lane] = (bf16_t)f2bf(o1 / l);
}
__global__ void __launch_bounds__(256) k_branch_naive(const bf16_t* __restrict__ OC, const bf16_t* __restrict__ Wt, const bf16_t* __restrict__ P, bf16_t* __restrict__ MG) {
    const int lane = threadIdx.x & 63, w = threadIdx.x >> 6, r32 = lane & 31, hi = lane >> 5;
    const long tile = (long)blockIdx.x * 4 + w; const int m0 = (int)(tile / 32) * 32, n0 = (int)(tile % 32) * 32;
    f32x16 tot = {};
    for (int br = 0; br < 3; ++br) { f32x16 acc = {};
        const bf16_t* ap = OC + (size_t)(m0 + r32) * 1536 + 512 * br + 8 * hi; const bf16_t* bp = Wt + (size_t)(n0 + r32) * 1536 + 512 * br + 8 * hi;
        for (int k = 0; k < 512; k += 16) acc = __builtin_amdgcn_mfma_f32_32x32x16_bf16(*(const bf16x8*)(ap + k), *(const bf16x8*)(bp + k), acc, 0, 0, 0);
#pragma unroll
        for (int r = 0; r < 16; ++r) tot[r] += acc[r] * bf2f(P[(size_t)(m0 + crow(r, hi)) * INW + C_GMB + 1024 * br + n0 + r32]); }
#pragma unroll
    for (int r = 0; r < 16; ++r) MG[(size_t)(m0 + crow(r, hi)) * D + n0 + r32] = (bf16_t)f2bf(tot[r]);
}
__global__ void k_norm2(const float* __restrict__ x, const float* __restrict__ Y1, const float* __restrict__ g1, const float* __restrict__ g2, float* __restrict__ X1, bf16_t* __restrict__ H2) {
    const int row = blockIdx.x * 4 + (threadIdx.x >> 6), lane = threadIdx.x & 63;
    const f32x4* yr = (const f32x4*)(Y1 + (size_t)row * D) + lane; const f32x4* xr = (const f32x4*)(x + (size_t)row * D) + lane;
    f32x4 v[4]; float s = 0.f;
#pragma unroll
    for (int j = 0; j < 4; ++j) { v[j] = yr[64 * j]; s += v[j].x * v[j].x + v[j].y * v[j].y + v[j].z * v[j].z + v[j].w * v[j].w; }
    const float r = rsqrtf(wave_sum(s) * (1.0f / D) + RMS_EPS); float s2 = 0.f;
#pragma unroll
    for (int j = 0; j < 4; ++j) { const f32x4 gg = ((const f32x4*)g1)[lane + 64 * j]; v[j] = xr[64 * j] + v[j] * r * gg; s2 += v[j].x * v[j].x + v[j].y * v[j].y + v[j].z * v[j].z + v[j].w * v[j].w;
        ((f32x4*)(X1 + (size_t)row * D))[lane + 64 * j] = v[j]; }
    const float r2 = rsqrtf(wave_sum(s2) * (1.0f / D) + RMS_EPS);
#pragma unroll
    for (int j = 0; j < 4; ++j) { const f32x4 gg = ((const f32x4*)g2)[lane + 64 * j]; unsigned long long o = (unsigned long long)(f2bf(v[j].x * r2 * gg.x) | (f2bf(v[j].y * r2 * gg.y) << 16)) | ((unsigned long long)(f2bf(v[j].z * r2 * gg.z) | (f2bf(v[j].w * r2 * gg.w) << 16)) << 32);
        ((unsigned long long*)(H2 + (size_t)row * D))[lane + 64 * j] = o; }
}
__global__ void k_final(const float* __restrict__ Y2, const float* __restrict__ g, float* __restrict__ out) {
    const int row = blockIdx.x * 4 + (threadIdx.x >> 6), lane = threadIdx.x & 63;
    const f32x4* yr = (const f32x4*)(Y2 + (size_t)row * D) + lane; f32x4* xr = (f32x4*)(out + (size_t)row * D) + lane;
    f32x4 v[4]; float s = 0.f;
#pragma unroll
    for (int j = 0; j < 4; ++j) { v[j] = yr[64 * j]; s += v[j].x * v[j].x + v[j].y * v[j].y + v[j].z * v[j].z + v[j].w * v[j].w; }
    const float r = rsqrtf(wave_sum(s) * (1.0f / D) + RMS_EPS);
#pragma unroll
    for (int j = 0; j < 4; ++j) { const f32x4 gg = ((const f32x4*)g)[lane + 64 * j]; xr[64 * j] = xr[64 * j] + v[j] * r * gg; }
}
__global__ void __launch_bounds__(256) k_up_naive(const bf16_t* __restrict__ H2, const bf16_t* __restrict__ Wt, const float* __restrict__ convp, bf16_t* __restrict__ ACT) {
    const int lane = threadIdx.x & 63, w = threadIdx.x >> 6, r32 = lane & 31, hi = lane >> 5;
    const long tile = (long)blockIdx.x * 4 + w; const int m0 = (int)(tile / (FF / 32)) * 32, c0 = (int)(tile % (FF / 32)) * 32;
    const int grow = 256 * (c0 >> 7) + (c0 & 127);
    f32x16 ag[3] = {}, av[3] = {};
    const int trow = m0 + r32, spos = trow % SEQ;
    const bf16_t* bg = Wt + (size_t)(grow + r32) * D + 8 * hi; const bf16_t* bv = bg + (size_t)128 * D;
    for (int k = 0; k < D; k += 16) { const bf16x8 g = *(const bf16x8*)(bg + k), v = *(const bf16x8*)(bv + k);
#pragma unroll
        for (int s = 0; s < 3; ++s) { bf16x8 a = {}; if (spos - s >= 0) a = *(const bf16x8*)(H2 + (size_t)(trow - s) * D + 8 * hi + k);
            ag[s] = __builtin_amdgcn_mfma_f32_32x32x16_bf16(a, g, ag[s], 0, 0, 0); av[s] = __builtin_amdgcn_mfma_f32_32x32x16_bf16(a, v, av[s], 0, 0, 0); } }
    const int colg = grow + r32, colv = colg + 128;
    const float wg0 = convp[colg], wg1 = convp[UPW + colg], wg2 = convp[2 * UPW + colg], bgc = convp[3 * UPW + colg];
    const float wv0 = convp[colv], wv1 = convp[UPW + colv], wv2 = convp[2 * UPW + colv], bvc = convp[3 * UPW + colv];
#pragma unroll
    for (int r = 0; r < 16; ++r) { const float ug = bgc + wg2 * ag[0][r] + wg1 * ag[1][r] + wg0 * ag[2][r], uv = bvc + wv2 * av[0][r] + wv1 * av[1][r] + wv0 * av[2][r];
        ACT[(size_t)(m0 + crow(r, hi)) * FF + c0 + r32] = (bf16_t)f2bf(gelu_tanh(ug) * uv); }
}


#define LAS __attribute__((address_space(3)))
#define GAS __attribute__((address_space(1)))
typedef float f32x2 __attribute__((ext_vector_type(2)));
typedef unsigned u32x2 __attribute__((ext_vector_type(2)));
typedef short s16x4 __attribute__((ext_vector_type(4)));
typedef __bf16 bf16x2_t __attribute__((ext_vector_type(2)));
__device__ __forceinline__ unsigned cvt_pk_bf16(float lo, float hi) { f32x2 v = {lo, hi}; bf16x2_t b = __builtin_convertvector(v, bf16x2_t); return __builtin_bit_cast(unsigned, b); }
__device__ __forceinline__ float fast_exp2(float x) { return __builtin_amdgcn_exp2f(x); }
__device__ __forceinline__ float fast_rcp(float x) { return __builtin_amdgcn_rcpf(x); }
__device__ __forceinline__ float fast_sigmoid(float x) { return fast_rcp(1.0f + fast_exp2(-LOG2E * x)); }
__device__ __forceinline__ float fast_gelu(float x) { const float x2 = x * x; const float t = x * (-2.302208198f - 0.102943234f * x2); return x * fast_rcp(1.0f + fast_exp2(t)); }

namespace pg8 {
constexpr int BM = 256, BK = 64, HALF = 128, HTB = HALF * BK * 2, STAGE_BYTES = 8 * HTB, NXCD = 8, WGM = 8;
__host__ __device__ __forceinline__ int lds_byte(int r, int c) { const int st = (r >> 4) * 2 + (c >> 5), rr = r & 15, cc = c & 31, ob = rr * 64 + cc * 2; return st * 1024 + (ob ^ (((ob >> 9) & 1) << 5)); }
__host__ __device__ __forceinline__ void stage_rc(int b, int& R, int& C) { const int st = b / 1024, sb = b % 1024, swz = sb ^ (((sb >> 9) & 1) << 5); R = (st >> 1) * 16 + swz / 64; C = (st & 1) * 32 + (swz % 64) / 2; }
__host__ __device__ __forceinline__ int perm32(int rho) { const int n = rho >> 4, i = rho & 15; return 8 * (i >> 2) + 4 * n + (i & 3); }

struct Unit { int pm, pn, sub; };
struct Gemm { const bf16_t* A; const bf16_t* Bt; int lda, ldb, K; };

struct StaticOrder {
    int nM, nN, nwg, G, c;
    __device__ void init(int M, int N, int G_, int c_) { nM = M / BM; nN = N / BM; nwg = nM * nN; G = G_; c = c_; }
    __device__ bool tile(long L, Unit& u) const {
        if (L >= nwg) return false;
        int wgid = (int)L; { const int q = nwg / NXCD, r = nwg % NXCD, xcd = wgid % NXCD, off = wgid / NXCD; wgid = (xcd < r ? xcd * (q + 1) : r * (q + 1) + (xcd - r) * q) + off; }
        const int nig = WGM * nN, gid = wgid / nig, fm = gid * WGM, gsz = (nM - fm) < WGM ? (nM - fm) : WGM;
        u.pm = fm + ((wgid % nig) % gsz); u.pn = (wgid % nig) / gsz; u.sub = 0; return true;
    }
    __device__ bool next(int i, Unit& u) const { return tile((long)i * G + c, u); }
};
struct SubOrder3 : StaticOrder {
    __device__ bool next(int i, Unit& u) const { const int t = i / 3; if (!tile((long)t * G + c, u)) return false; u.sub = i - 3 * t; return true; }
};
struct FewOrder {
    int nN, nu, c0, c;
    __device__ bool next(int i, Unit& u) const { const int k = c - c0; if (i > 0 || k < 0 || k >= nu) return false; u.pm = k / nN; u.pn = k % nN; u.sub = 0; return true; }
};
typedef f32x4 Acc[2][2][4][2];
__device__ __forceinline__ void zero_acc(Acc& acc) {
#pragma unroll
    for (int a = 0; a < 2; ++a)
#pragma unroll
        for (int b = 0; b < 2; ++b)
#pragma unroll
            for (int m = 0; m < 4; ++m)
#pragma unroll
                for (int n = 0; n < 2; ++n) acc[a][b][m][n] = (f32x4){0.f, 0.f, 0.f, 0.f};
}
template <class Epi, class Sched>
__device__ __forceinline__ void gemm_phase(LAS unsigned char* lds, const Gemm g, const Sched& S, const Epi& E) {
    const int tid = threadIdx.x, wid = __builtin_amdgcn_readfirstlane(tid >> 6), lane = tid & 63, wr = wid >> 2, wc = wid & 3, fr = lane & 15, fq = lane >> 4;
    const int K = g.K, nt = K / BK;
    unsigned voffA[2], voffB[2];
#pragma unroll
    for (int i = 0; i < 2; ++i) { int R, C; stage_rc(tid * 16 + i * 8192, R, C); const int Rb = Epi::PERM ? ((R & ~31) + perm32(R & 31)) : R;
        voffA[i] = (unsigned)(R * g.lda + C) * 2u; voffB[i] = (unsigned)(Rb * g.ldb + C) * 2u; }
    const size_t kstep = (size_t)(BK * 2);
    const size_t hstepA = (size_t)HALF * g.lda * 2, hstepB = (size_t)HALF * g.ldb * 2;
    const unsigned ldsw = (unsigned)wid * 1024u;
    const int aoff = lds_byte(wr * 64 + fr, fq * 8), boff = lds_byte(wc * 32 + fr, fq * 8);
#define PG8_UA(u) ((const char*)g.A + ((size_t)(u).pm * BM * g.lda + (size_t)(u).sub * K) * 2)
#define PG8_UB(u) ((const char*)g.Bt + ((size_t)(u).pn * BM * g.ldb + (size_t)(u).sub * K) * 2)
#define PG8_SA(b, h) (((b) * 2 + (h)) * HTB)
#define PG8_SB(b, h) ((4 + (b) * 2 + (h)) * HTB)
#define PG8_STAGE(bufoff, gbase, voff) do { _Pragma("unroll") for (int _i = 0; _i < 2; ++_i) \
        __builtin_amdgcn_global_load_lds((const unsigned*)((const char*)(gbase) + (voff)[_i]), (LAS unsigned*)(lds + (bufoff) + ldsw + _i * 8192), 16, 0, 0); } while (0)
#define PG8_LDA(dst, b, h) do { _Pragma("unroll") for (int m = 0; m < 4; ++m) _Pragma("unroll") for (int k = 0; k < 2; ++k) dst[m][k] = *(const LAS bf16x8*)(lds + PG8_SA(b, h) + aoff + m * 2048 + k * 1024); } while (0)
#define PG8_LDB(dst, b, h) do { _Pragma("unroll") for (int n = 0; n < 2; ++n) _Pragma("unroll") for (int k = 0; k < 2; ++k) dst[n][k] = *(const LAS bf16x8*)(lds + PG8_SB(b, h) + boff + n * 2048 + k * 1024); } while (0)
#define PG8_MMA(ai, bj, At, Bt) do { __builtin_amdgcn_s_setprio(1); _Pragma("unroll") for (int m = 0; m < 4; ++m) _Pragma("unroll") for (int n = 0; n < 2; ++n) _Pragma("unroll") for (int k = 0; k < 2; ++k) \
        acc[ai][bj][m][n] = __builtin_amdgcn_mfma_f32_16x16x32_bf16(Bt[n][k], At[m][k], acc[ai][bj][m][n], 0, 0, 0); __builtin_amdgcn_s_setprio(0); } while (0)
#define PG8_WAIT_V(n) asm volatile("s_waitcnt vmcnt(" #n ")" ::: "memory")
#define PG8_WAIT_L(n) asm volatile("s_waitcnt lgkmcnt(" #n ")" ::: "memory")
#define PG8_BAR __builtin_amdgcn_s_barrier()
#define PG8_SCHED __builtin_amdgcn_sched_barrier(0)
    Unit cur, nxt; int ui = 0;
    if (!S.next(0, cur)) return;
    Acc acc; zero_acc(acc);
    bf16x8 At[4][2], B0[2][2], B1[2][2];
    const char* cA = PG8_UA(cur); const char* cB = PG8_UB(cur);
    PG8_STAGE(PG8_SB(0, 0), cB, voffB); PG8_STAGE(PG8_SB(0, 1), cB + hstepB, voffB); PG8_STAGE(PG8_SA(0, 0), cA, voffA); PG8_STAGE(PG8_SA(0, 1), cA + hstepA, voffA);
    if (wr == 1) PG8_BAR;
    PG8_WAIT_V(2); PG8_BAR;
    PG8_STAGE(PG8_SB(1, 0), cB + kstep, voffB); PG8_STAGE(PG8_SA(1, 0), cA + kstep, voffA); PG8_STAGE(PG8_SB(1, 1), cB + hstepB + kstep, voffB);
    PG8_WAIT_V(6); PG8_BAR;
    for (;;) {
        const bool has_next = S.next(ui + 1, nxt);
        const char* nA = has_next ? PG8_UA(nxt) : cA; const char* nB = has_next ? PG8_UB(nxt) : cB;
        for (int t = 0; t < nt; t += 2) {
            const bool last = (t == nt - 2);
            const char* a1 = cA + (size_t)(t + 1) * kstep;
            const char* a2 = last ? nA : cA + (size_t)(t + 2) * kstep; const char* b2 = last ? nB : cB + (size_t)(t + 2) * kstep;
            const char* a3 = a2 + kstep; const char* b3 = b2 + kstep;
            PG8_LDB(B0, 0, 0); PG8_LDB(B1, 0, 1); PG8_SCHED; PG8_LDA(At, 0, 0); PG8_STAGE(PG8_SA(1, 1), a1 + hstepA, voffA);
            PG8_WAIT_V(8); PG8_WAIT_L(0); PG8_BAR; PG8_MMA(0, 0, At, B0); PG8_MMA(0, 1, At, B1); PG8_BAR; PG8_SCHED;
            PG8_LDA(At, 0, 1); PG8_STAGE(PG8_SB(0, 0), b2, voffB); PG8_STAGE(PG8_SB(0, 1), b2 + hstepB, voffB); PG8_STAGE(PG8_SA(0, 0), a2, voffA);
            PG8_WAIT_V(8); PG8_WAIT_L(0); PG8_BAR; PG8_MMA(1, 0, At, B0); PG8_MMA(1, 1, At, B1); PG8_BAR; PG8_SCHED;
            PG8_LDB(B0, 1, 0); PG8_LDB(B1, 1, 1); PG8_SCHED; PG8_LDA(At, 1, 0); PG8_STAGE(PG8_SA(0, 1), a2 + hstepA, voffA);
            PG8_WAIT_V(8); PG8_WAIT_L(0); PG8_BAR; PG8_MMA(0, 0, At, B0); PG8_MMA(0, 1, At, B1); PG8_BAR; PG8_SCHED;
            PG8_LDA(At, 1, 1); PG8_STAGE(PG8_SB(1, 0), b3, voffB); PG8_STAGE(PG8_SB(1, 1), b3 + hstepB, voffB); PG8_STAGE(PG8_SA(1, 0), a3, voffA);
            PG8_WAIT_V(8); PG8_WAIT_L(0); PG8_BAR; PG8_MMA(1, 0, At, B0); PG8_MMA(1, 1, At, B1); PG8_BAR; PG8_SCHED;
        }
        if (wr == 0) PG8_BAR;
        E(acc, cur, wr, wc, fr, fq);
        if (!has_next) break;
        cur = nxt; cA = nA; cB = nB; ++ui;
        if (wr == 1) PG8_BAR;
    }
    PG8_WAIT_V(0);
    PG8_BAR;
#undef PG8_UA
#undef PG8_UB
#undef PG8_SA
#undef PG8_SB
#undef PG8_STAGE
#undef PG8_LDA
#undef PG8_LDB
#undef PG8_MMA
#undef PG8_WAIT_V
#undef PG8_WAIT_L
#undef PG8_BAR
#undef PG8_SCHED
}

struct EpiF32 { static constexpr bool PERM = false; float* C; int ldc;
    __device__ __forceinline__ void operator()(Acc& acc, const Unit& u, int wr, int wc, int fr, int fq) const {
        const int row0 = u.pm * BM + wr * 64 + fr, col0 = u.pn * BM + wc * 32 + 4 * fq;
#pragma unroll
        for (int ai = 0; ai < 2; ++ai)
#pragma unroll
            for (int m = 0; m < 4; ++m) { float* rowp = C + (size_t)(row0 + ai * HALF + m * 16) * ldc + col0;
#pragma unroll
                for (int bj = 0; bj < 2; ++bj)
#pragma unroll
                    for (int n = 0; n < 2; ++n) *(f32x4*)(rowp + bj * HALF + n * 16) = acc[ai][bj][m][n]; }
        zero_acc(acc);
    } };
struct EpiBf16 { static constexpr bool PERM = true; bf16_t* O; int ldc;
    __device__ __forceinline__ void operator()(Acc& acc, const Unit& u, int wr, int wc, int fr, int fq) const {
        const int row0 = u.pm * BM + wr * 64 + fr, col0 = u.pn * BM + wc * 32 + 8 * fq;
#pragma unroll
        for (int ai = 0; ai < 2; ++ai)
#pragma unroll
            for (int m = 0; m < 4; ++m) { bf16_t* rowp = O + (size_t)(row0 + ai * HALF + m * 16) * ldc + col0;
#pragma unroll
                for (int bj = 0; bj < 2; ++bj) { const f32x4 v0 = acc[ai][bj][m][0], v1 = acc[ai][bj][m][1];
                    u32x4 w; w.x = cvt_pk_bf16(v0[0], v0[1]); w.y = cvt_pk_bf16(v0[2], v0[3]); w.z = cvt_pk_bf16(v1[0], v1[1]); w.w = cvt_pk_bf16(v1[2], v1[3]);
                    *(u32x4*)(rowp + bj * HALF) = w; } }
        zero_acc(acc);
    } };
struct EpiProj { static constexpr bool PERM = true; bf16_t* P; float* kmean;
    __device__ __forceinline__ void operator()(Acc& acc, const Unit& u, int wr, int wc, int fr, int fq) const {
        const int pn = u.pn; const int row0 = u.pm * BM + wr * 64 + fr, col0 = pn * BM + wc * 32 + 8 * fq;
        const float sc = (pn < 2 || pn == 6 || pn == 7) ? C2_64 : (pn == 9 || pn == 10) ? C2_128 : 1.0f; const bool sg = pn >= 11;
#pragma unroll
        for (int ai = 0; ai < 2; ++ai)
#pragma unroll
            for (int m = 0; m < 4; ++m) { bf16_t* rowp = P + (size_t)(row0 + ai * HALF + m * 16) * INW + col0;
#pragma unroll
                for (int bj = 0; bj < 2; ++bj) { f32x4 v0 = acc[ai][bj][m][0] * sc, v1 = acc[ai][bj][m][1] * sc;
                    if (sg) {
#pragma unroll
                        for (int j = 0; j < 4; ++j) { v0[j] = fast_sigmoid(v0[j]); v1[j] = fast_sigmoid(v1[j]); } }
                    u32x4 w; w.x = cvt_pk_bf16(v0[0], v0[1]); w.y = cvt_pk_bf16(v0[2], v0[3]); w.z = cvt_pk_bf16(v1[0], v1[1]); w.w = cvt_pk_bf16(v1[2], v1[3]);
                    *(u32x4*)(rowp + bj * HALF) = w; } }
        if (pn == 2 || pn == 3) {
            float* kb = kmean + ((size_t)(u.pm >> 5) * 8 * NBLK + (u.pm & 31)) * 64;
#pragma unroll
            for (int bj = 0; bj < 2; ++bj)
#pragma unroll
                for (int n = 0; n < 2; ++n)
#pragma unroll
                    for (int j = 0; j < 4; ++j) { float s = 0.f;
#pragma unroll
                        for (int ai = 0; ai < 2; ++ai)
#pragma unroll
                            for (int m = 0; m < 4; ++m) s += acc[ai][bj][m][n][j];
                        s += __shfl_xor(s, 1); s += __shfl_xor(s, 2); s += __shfl_xor(s, 4); s += __shfl_xor(s, 8);
                        const int hd = (pn - 2) * 256 + bj * 128 + wc * 32 + 8 * fq + 4 * n + j;
                        if (fr == 0) atomicAdd(kb + (size_t)(hd >> 6) * NBLK * 64 + (hd & 63), s * (1.0f / MBLK)); } }
        zero_acc(acc);
    } };
struct EpiBranch { static constexpr bool PERM = true; const bf16_t* P; bf16_t* MG;
    __device__ __forceinline__ void operator()(Acc& acc, const Unit& u, int wr, int wc, int fr, int fq) const {
        const int row0 = u.pm * BM + wr * 64 + fr, col0 = u.pn * BM + wc * 32 + 8 * fq; const int sub = u.sub;
#pragma unroll
        for (int ai = 0; ai < 2; ++ai) {
            u32x4 ga[4][2], gb[4][2];
#pragma unroll
            for (int m = 0; m < 4; ++m)
#pragma unroll
                for (int bj = 0; bj < 2; ++bj) { const bf16_t* gp = P + (size_t)(row0 + ai * HALF + m * 16) * INW + C_GMB + 1024 * sub + col0 + bj * HALF;
                    ga[m][bj] = *(const u32x4*)gp; gb[m][bj] = (sub < 2) ? *(const u32x4*)(gp + 1024) : (u32x4){0x3f803f80u, 0x3f803f80u, 0x3f803f80u, 0x3f803f80u}; }
#pragma unroll
            for (int m = 0; m < 4; ++m) { const size_t row = (size_t)(row0 + ai * HALF + m * 16);
#pragma unroll
                for (int bj = 0; bj < 2; ++bj) { float f[8];
#pragma unroll
                    for (int j = 0; j < 4; ++j) { f[2 * j] = __builtin_bit_cast(float, ga[m][bj][j] << 16); f[2 * j + 1] = __builtin_bit_cast(float, ga[m][bj][j] & 0xffff0000u); }
                    if (sub < 2) {
#pragma unroll
                        for (int j = 0; j < 4; ++j) { f[2 * j] *= fast_rcp(fmaxf(__builtin_bit_cast(float, gb[m][bj][j] << 16), 1e-20f)); f[2 * j + 1] *= fast_rcp(fmaxf(__builtin_bit_cast(float, gb[m][bj][j] & 0xffff0000u), 1e-20f)); } }
                    f32x4 v0 = acc[ai][bj][m][0], v1 = acc[ai][bj][m][1];
                    v0[0] *= f[0]; v0[1] *= f[1]; v0[2] *= f[2]; v0[3] *= f[3]; v1[0] *= f[4]; v1[1] *= f[5]; v1[2] *= f[6]; v1[3] *= f[7];
                    if (sub == 2) { u32x4 w; w.x = cvt_pk_bf16(v0[0], v0[1]); w.y = cvt_pk_bf16(v0[2], v0[3]); w.z = cvt_pk_bf16(v1[0], v1[1]); w.w = cvt_pk_bf16(v1[2], v1[3]);
                        *(u32x4*)(MG + row * D + col0 + bj * HALF) = w; v0 = (f32x4){0.f, 0.f, 0.f, 0.f}; v1 = v0; }
                    acc[ai][bj][m][0] = v0; acc[ai][bj][m][1] = v1; } } }
    } };
__device__ __forceinline__ float dpp_ror(float v, int n) { return n == 1 ? __builtin_bit_cast(float, __builtin_amdgcn_update_dpp(0, __builtin_bit_cast(int, v), 0x121, 0xf, 0xf, false))
                                                                         : __builtin_bit_cast(float, __builtin_amdgcn_update_dpp(0, __builtin_bit_cast(int, v), 0x122, 0xf, 0xf, false)); }
__device__ __forceinline__ float dpp_shr(float old, float v, int n) { return n == 1 ? __builtin_bit_cast(float, __builtin_amdgcn_update_dpp(__builtin_bit_cast(int, old), __builtin_bit_cast(int, v), 0x111, 0xf, 0xf, false))
                                                                                   : __builtin_bit_cast(float, __builtin_amdgcn_update_dpp(__builtin_bit_cast(int, old), __builtin_bit_cast(int, v), 0x112, 0xf, 0xf, false)); }
struct EpiUp { static constexpr bool PERM = true; bf16_t* ACT; bf16_t* EDGE; const float* convp;
    __device__ __forceinline__ void operator()(Acc& acc, const Unit& u, int wr, int wc, int fr, int fq) const {
        const int row0 = u.pm * BM + wr * 64 + fr; const int tcol = u.pn * BM + wc * 32 + 8 * fq;
        const int ch0 = u.pn * 128 + wc * 32 + 8 * fq;
#pragma unroll
        for (int n = 0; n < 2; ++n) {
            const float* cp = convp + tcol + 4 * n;
            const f32x4 g0 = *(const f32x4*)(cp), g1 = *(const f32x4*)(cp + UPW), g2 = *(const f32x4*)(cp + 2 * UPW), gb = *(const f32x4*)(cp + 3 * UPW);
            const f32x4 w0 = *(const f32x4*)(cp + HALF), w1 = *(const f32x4*)(cp + HALF + UPW), w2 = *(const f32x4*)(cp + HALF + 2 * UPW), wb = *(const f32x4*)(cp + HALF + 3 * UPW);
#pragma unroll
            for (int ai = 0; ai < 2; ++ai) {
                const int g64 = (u.pm * BM + ai * HALF + wr * 64) >> 6;
#pragma unroll
                for (int m = 0; m < 4; ++m) {
                    const f32x4 cg = acc[ai][0][m][n], cv = acc[ai][1][m][n];
                    f32x4 pg = cg, pv = cv; if (m > 0) { pg = acc[ai][0][m - 1][n]; pv = acc[ai][1][m - 1][n]; }
                    f32x4 og, ov;
#pragma unroll
                    for (int j = 0; j < 4; ++j) {
                        const float a1 = dpp_shr(dpp_ror(pg[j], 1), cg[j], 1), a2 = dpp_shr(dpp_ror(pg[j], 2), cg[j], 2);
                        const float b1 = dpp_shr(dpp_ror(pv[j], 1), cv[j], 1), b2 = dpp_shr(dpp_ror(pv[j], 2), cv[j], 2);
                        const float ug = gb[j] + g2[j] * cg[j] + g1[j] * a1 + g0[j] * a2, uv = wb[j] + w2[j] * cv[j] + w1[j] * b1 + w0[j] * b2;
                        og[j] = ug; ov[j] = uv; }
                    u32x2 w; w.x = cvt_pk_bf16(fast_gelu(og[0]) * ov[0], fast_gelu(og[1]) * ov[1]); w.y = cvt_pk_bf16(fast_gelu(og[2]) * ov[2], fast_gelu(og[3]) * ov[3]);
                    if (m > 0 || fr >= 2) *(u32x2*)(ACT + (size_t)(row0 + ai * HALF + m * 16) * FF + ch0 + 4 * n) = w;
                    if ((m == 0 && fr < 2) || (m == 3 && fr >= 14)) {
                        const int e = (m == 0) ? fr : fr - 12; bf16_t* ep = EDGE + ((size_t)g64 * 4 + e) * UPW + tcol + 4 * n;
                        u32x2 r0, r1; r0.x = cvt_pk_bf16(cg[0], cg[1]); r0.y = cvt_pk_bf16(cg[2], cg[3]); r1.x = cvt_pk_bf16(cv[0], cv[1]); r1.y = cvt_pk_bf16(cv[2], cv[3]);
                        *(u32x2*)ep = r0; *(u32x2*)(ep + HALF) = r1; }
                } } }
        zero_acc(acc);
    } };
}
namespace att {
typedef LAS const char* lds_cptr;
typedef short v4i16_t __attribute__((ext_vector_type(4)));
constexpr int L_K0 = 0, L_K1 = 16384, L_V0 = 32768, L_V1 = 49152, L_TAB = 65536, L_MISC = 73728;
#define ATT_WAIT_BAR() asm volatile("s_waitcnt vmcnt(0) lgkmcnt(0)\n\ts_barrier" ::: "memory")
#define ATT_MFMA(a, b, c) __builtin_amdgcn_mfma_f32_32x32x16_bf16(a, b, c, 0, 0, 0)
__device__ __forceinline__ void glds16(const void* g, unsigned lds_base) {
    unsigned sv; asm volatile("s_mov_b32 %0, m0\n\ts_mov_b32 m0, %2\n\ts_nop 0\n\tglobal_load_lds_dwordx4 %1, off\n\ts_mov_b32 m0, %0" : "=&s"(sv) : "v"(g), "s"(lds_base) : "memory"); }
__device__ __forceinline__ s16x4 vtr(lds_cptr p) { return __builtin_bit_cast(s16x4, __builtin_amdgcn_ds_read_tr16_b64_v4i16((LAS v4i16_t*)p)); }

template <int DH> struct State { f32x16 o[DH / 32]; float m, l; };
template <int DH> __device__ __forceinline__ void init_state(State<DH>& s, float m0, float l0) {
#pragma unroll
    for (int i = 0; i < DH / 32; ++i) s.o[i] = f32x16{};
    s.m = m0; s.l = l0; }

template <int DH> __device__ __forceinline__ void stage_tile(unsigned lds0, int kbuf, int vbuf, const bf16_t* krow0, const bf16_t* vrow0, size_t pitch, int wid, int lane) {
#pragma unroll
    for (int i = 0; i < DH / 64; ++i) { const int ch = wid + 8 * i;
        glds16(krow0 + (size_t)lane * pitch + ch * 8, (unsigned)__builtin_amdgcn_readfirstlane(lds0 + kbuf + ch * 1024)); }
#pragma unroll
    for (int i = 0; i < DH / 64; ++i) { const int p = wid + 8 * i, db = p >> 2, rg = p & 3;
        glds16(vrow0 + (size_t)(16 * rg + (lane >> 2)) * pitch + 32 * db + 8 * (lane & 3), (unsigned)__builtin_amdgcn_readfirstlane(lds0 + vbuf + p * 1024)); }
}
template <int DH, class BiasF> __device__ __forceinline__ void tile_step(State<DH>& st, lds_cptr kb, lds_cptr vb, const bf16x8 (&qr)[DH / 16], const BiasF& bias, int lane) {
    const int r32 = lane & 31, hi = lane >> 5;
    f32x16 p0 = f32x16{}, p1 = f32x16{};
    const lds_cptr kp = kb + hi * 1024 + r32 * 16;
#pragma unroll
    for (int d0 = 0; d0 < DH / 16; ++d0) { const bf16x8 k0 = *(const LAS bf16x8*)(kp + d0 * 2048), k1 = *(const LAS bf16x8*)(kp + d0 * 2048 + 512);
        p0 = ATT_MFMA(k0, qr[d0], p0); p1 = ATT_MFMA(k1, qr[d0], p1); }
    bias(p0, p1);
    float rm = fmaxf(p0[0], p1[0]);
#pragma unroll
    for (int r = 1; r < 16; ++r) rm = fmaxf(rm, fmaxf(p0[r], p1[r]));
    rm = fmaxf(rm, __shfl_xor(rm, 32));
    const float mn = fmaxf(st.m, rm), alpha = fast_exp2(st.m - mn); st.m = mn;
    float ls = 0.f;
#pragma unroll
    for (int r = 0; r < 16; ++r) { p0[r] = fast_exp2(p0[r] - mn); p1[r] = fast_exp2(p1[r] - mn); ls += p0[r] + p1[r]; }
    st.l = st.l * alpha + ls;
#pragma unroll
    for (int i = 0; i < DH / 32; ++i)
#pragma unroll
        for (int r = 0; r < 16; ++r) st.o[i][r] *= alpha;
    u32x4 pw[4];
#pragma unroll
    for (int j = 0; j < 4; ++j) { pw[0][j] = cvt_pk_bf16(p0[2 * j], p0[2 * j + 1]); pw[1][j] = cvt_pk_bf16(p0[8 + 2 * j], p0[9 + 2 * j]); pw[2][j] = cvt_pk_bf16(p1[2 * j], p1[2 * j + 1]); pw[3][j] = cvt_pk_bf16(p1[8 + 2 * j], p1[9 + 2 * j]); }
    const lds_cptr vp = vb + ((lane >> 4) & 1) * 32 + (lane & 3) * 8 + (4 * hi + ((lane & 15) >> 2)) * 64;
#pragma unroll
    for (int ks = 0; ks < 4; ++ks)
#pragma unroll
        for (int db = 0; db < DH / 32; ++db) { const s16x4 lo = vtr(vp + db * 4096 + ks * 1024), up = vtr(vp + db * 4096 + ks * 1024 + 512);
            const bf16x8 vf = (bf16x8){lo[0], lo[1], lo[2], lo[3], up[0], up[1], up[2], up[3]};
            st.o[db] = ATT_MFMA(vf, __builtin_bit_cast(bf16x8, pw[ks]), st.o[db]); }
}
template <int DH, class BiasMk> __device__ __forceinline__ void run_tiles(State<DH>& st, LAS unsigned char* lds, const bf16_t* qrow, const bf16_t* ktile0, const bf16_t* vtile0, size_t pitch,
                                                                           int t_lo, int t_hi, unsigned need, const BiasMk& mk, int wid, int lane) {
    const unsigned lds0 = (unsigned)(uintptr_t)lds; const int hi = lane >> 5;
    stage_tile<DH>(lds0, L_K0, L_V0, ktile0 + (size_t)t_lo * 64 * pitch, vtile0 + (size_t)t_lo * 64 * pitch, pitch, wid, lane);
    bf16x8 qr[DH / 16];
#pragma unroll
    for (int d0 = 0; d0 < DH / 16; ++d0) qr[d0] = *(const bf16x8*)(qrow + d0 * 16 + hi * 8);
    for (int t = t_lo; t < t_hi; ++t) {
        const int par = (t - t_lo) & 1;
        ATT_WAIT_BAR();
        if (t + 1 < t_hi) stage_tile<DH>(lds0, par ? L_K0 : L_K1, par ? L_V0 : L_V1, ktile0 + (size_t)(t + 1) * 64 * pitch, vtile0 + (size_t)(t + 1) * 64 * pitch, pitch, wid, lane);
        if ((need >> t) & 1u) tile_step<DH>(st, (lds_cptr)lds + (par ? L_K1 : L_K0), (lds_cptr)lds + (par ? L_V1 : L_V0), qr, mk(t), lane);
    }
    ATT_WAIT_BAR();
}
struct NoBias { __device__ __forceinline__ void operator()(f32x16&, f32x16&) const {} };
struct MkNoBias { __device__ __forceinline__ NoBias operator()(int) const { return NoBias{}; } };
template <bool WIN> struct DistBias { const LAS float* tab; int base;
    __device__ __forceinline__ void operator()(f32x16& p0, f32x16& p1) const {
        if (!WIN) { const int dmin = base - 63; if (__all(dmin >= 127)) { const float c = tab[127];
#pragma unroll
                for (int r = 0; r < 16; ++r) { p0[r] += c; p1[r] += c; }
                return; } }
#pragma unroll
        for (int r = 0; r < 16; ++r) { const int cr = (r & 3) + 8 * (r >> 2); const int d0 = base - cr, d1 = d0 - 32;
            const float b0 = tab[d0 < 0 ? 0 : (d0 > 127 ? 127 : d0)], b1 = tab[d1 < 0 ? 0 : (d1 > 127 ? 127 : d1)];
            p0[r] = (d0 >= 0 && (!WIN || d0 < 128)) ? p0[r] + b0 : -INFINITY; p1[r] = (d1 >= 0 && (!WIN || d1 < 128)) ? p1[r] + b1 : -INFINITY; }
    } };
template <bool WIN> struct MkDistBias { const LAS float* tab; int dq, hi; __device__ __forceinline__ DistBias<WIN> operator()(int t) const { return DistBias<WIN>{tab, dq - 64 * t - 4 * hi}; } };

template <int DH> __device__ __forceinline__ void store_rows(const State<DH>& st, float ltot, bf16_t* orow, bool valid, int hi) {
    const float inv = fast_rcp(ltot);
    if (valid) {
#pragma unroll
        for (int db = 0; db < DH / 32; ++db)
#pragma unroll
            for (int g = 0; g < 4; ++g) { u32x2 w; w.x = cvt_pk_bf16(st.o[db][4 * g] * inv, st.o[db][4 * g + 1] * inv); w.y = cvt_pk_bf16(st.o[db][4 * g + 2] * inv, st.o[db][4 * g + 3] * inv);
                *(u32x2*)(orow + 32 * db + 8 * g + 4 * hi) = w; } }
}
}
constexpr size_t WS_BARW = 0;
constexpr int CW_BAR = 4096;
constexpr size_t WS_LCNT = 256 * 1024;
constexpr size_t WS_CNT = 42 * MiB;
constexpr size_t WS_PO01 = 44 * MiB;
constexpr size_t WS_PO2 = 476 * MiB;
constexpr size_t DO_PL = 96 * MiB, DO_SEG = 100 * MiB;
constexpr int RING_BYTES = 131072, LDSCTL_OFF = RING_BYTES, MISC_OFF = LDSCTL_OFF + 320, LDS_BYTES = 147456;
constexpr int NWAVES = 8;
constexpr int NPHASE = 12;

#define XB_TMO      128
#define XB_XCNT(j)  (256  + 64 * (j))
#define XB_XSUB(j)  (1280 + 64 * (j))
#define XB_XGEN(j)  (2304 + 64 * (j))
#define XB_TOP      3328
#define XB_TOPGEN   3392
#define XCD_BAR_WORDS 3456
#define XB_SPIN_CAP (1u << 18)

__device__ __forceinline__ unsigned xb_ld(unsigned* p)              { return __hip_atomic_load(p, __ATOMIC_RELAXED, __HIP_MEMORY_SCOPE_AGENT); }
__device__ __forceinline__ unsigned xb_add(unsigned* p, unsigned v) { return __hip_atomic_fetch_add(p, v, __ATOMIC_RELAXED, __HIP_MEMORY_SCOPE_AGENT); }
__device__ __forceinline__ unsigned xb_xcc_id() { return (unsigned)__builtin_amdgcn_s_getreg((3 << 11) | 20) & 0xFu; }
#define XB_SPIN(cond, bar) do { unsigned _sp = 0; while (cond) { __builtin_amdgcn_s_sleep(1); \
    if ((++_sp & 255u) == 0u) { if (xb_ld(&(bar)[XB_TMO])) break; if (_sp > XB_SPIN_CAP) { atomicAdd(&(bar)[XB_TMO], 1u); break; } } } } while (0)

struct XcdBarrier {
    unsigned* bar; unsigned x;
    volatile LAS unsigned* st;
};

__device__ __forceinline__ XcdBarrier xcd_barrier_post(unsigned* bar, volatile LAS unsigned* st) {
    XcdBarrier b; b.bar = bar; b.x = xb_xcc_id(); b.st = st;
    if (threadIdx.x == 0) (void)xb_add(&bar[XB_XCNT(b.x)], 1u);
    return b;
}
__device__ __forceinline__ void xcd_barrier_complete(unsigned* bar, unsigned x, unsigned& nloc, unsigned& nx) {
    const unsigned G = gridDim.x * gridDim.y * gridDim.z;
    unsigned sum, cnt, mine, sp = 0u;
    for (;;) {
        sum = 0u; cnt = 0u; mine = 0u;
#pragma unroll
        for (unsigned j = 0; j < 16; ++j) { const unsigned c = xb_ld(&bar[XB_XCNT(j)]); sum += c; cnt += (c > 0u) ? 1u : 0u; mine = (j == x) ? c : mine; }
        if (sum == G) break;
        __builtin_amdgcn_s_sleep(1);
        if ((++sp & 255u) == 0u) { if (xb_ld(&bar[XB_TMO])) break; if (sp > XB_SPIN_CAP) { atomicAdd(&bar[XB_TMO], 1u); break; } }
    }
    nloc = mine > 0u ? mine : 1u; nx = cnt > 0u ? cnt : 1u;
}

__device__ __forceinline__ void xcd_barrier(const XcdBarrier& b) {
    asm volatile("s_waitcnt vmcnt(0)" ::: "memory");
    __syncthreads();
    if (threadIdx.x == 0) {
        unsigned* bar = b.bar;
        __builtin_amdgcn_s_waitcnt(0);
        unsigned nloc = b.st[0], nx = b.st[1];
        if (nloc == 0u) { xcd_barrier_complete(bar, b.x, nloc, nx); b.st[0] = nloc; b.st[1] = nx; }
        const unsigned old = xb_add(&bar[XB_XSUB(b.x)], 1u);
        const unsigned gen = old / nloc;
        if (old + 1u == (gen + 1u) * nloc) {
            __builtin_amdgcn_fence(__ATOMIC_RELEASE, "agent");
            asm volatile("s_waitcnt vmcnt(0)" ::: "memory");
            const unsigned og = xb_add(&bar[XB_TOP], 1u);
            const unsigned tg = og / nx;
            if (og + 1u == (tg + 1u) * nx) xb_add(&bar[XB_TOPGEN], 1u);
            else XB_SPIN(xb_ld(&bar[XB_TOPGEN]) == tg, bar);
            __builtin_amdgcn_fence(__ATOMIC_ACQUIRE, "agent");
            xb_add(&bar[XB_XGEN(b.x)], 1u);
            asm volatile("s_waitcnt vmcnt(0)" ::: "memory");
        } else {
            XB_SPIN(xb_ld(&bar[XB_XGEN(b.x)]) == gen, bar);
            __builtin_amdgcn_fence(__ATOMIC_ACQUIRE, "agent");
            asm volatile("s_waitcnt vmcnt(0)" ::: "memory");
        }
    }
    __syncthreads();
}


struct Args { const float* in[19]; float* out; unsigned char* ws; int ph_lo, ph_hi, li, pad; };

__device__ __forceinline__ unsigned long long pack4bf(float a, float b, float c, float d) { return (unsigned long long)(f2bf(a) | (f2bf(b) << 16)) | ((unsigned long long)(f2bf(c) | (f2bf(d) << 16)) << 32); }

template <int MAP> __device__ __forceinline__ void p0_transpose_item(const float* W, int K, int N, bf16_t* WT, int ld, int coff, LAS float* scr, int item, int lane) {
    const int nblk = N / 32, kb = item / nblk, nb = item % nblk, k0 = 64 * kb, n0 = 32 * nb;
#pragma unroll 8
    for (int i = 0; i < 32; ++i) { const int kk = 2 * i + (lane >> 5); scr[kk * 33 + (lane & 31)] = W[(size_t)(k0 + kk) * N + n0 + (lane & 31)]; }
    asm volatile("s_waitcnt lgkmcnt(0)" ::: "memory");
    const int c = lane & 7;
    int r0 = n0; if (MAP == 1) { const int isv = n0 >= FF, ch = isv ? n0 - FF : n0; r0 = 256 * (ch >> 7) + 128 * isv + (ch & 127); }
#pragma unroll
    for (int j = 0; j < 4; ++j) { const int n = (lane >> 3) + 8 * j; const LAS float* s = scr + (8 * c) * 33 + n;
        u32x4 o; o.x = f2bf(s[0 * 33]) | (f2bf(s[1 * 33]) << 16); o.y = f2bf(s[2 * 33]) | (f2bf(s[3 * 33]) << 16); o.z = f2bf(s[4 * 33]) | (f2bf(s[5 * 33]) << 16); o.w = f2bf(s[6 * 33]) | (f2bf(s[7 * 33]) << 16);
        *(u32x4*)(WT + (size_t)(r0 + n) * ld + coff + k0 + 8 * c) = o; }
    asm volatile("s_waitcnt lgkmcnt(0)" ::: "memory");
}
__device__ __forceinline__ void rms_row_bf16(const float* xrow, const float* g, bf16_t* orow, int lane) {
    const f32x4* xr = (const f32x4*)xrow + lane; f32x4 v[4]; float s = 0.f;
#pragma unroll
    for (int j = 0; j < 4; ++j) { v[j] = xr[64 * j]; s += v[j].x * v[j].x + v[j].y * v[j].y + v[j].z * v[j].z + v[j].w * v[j].w; }
    const float r = rsqrtf(wave_sum(s) * (1.0f / D) + RMS_EPS);
#pragma unroll
    for (int j = 0; j < 4; ++j) { const f32x4 gg = ((const f32x4*)g)[lane + 64 * j]; ((unsigned long long*)orow)[lane + 64 * j] = pack4bf(v[j].x * r * gg.x, v[j].y * r * gg.y, v[j].z * r * gg.z, v[j].w * r * gg.w); }
}

__global__ void __launch_bounds__(NWAVES * 64, 2) mega_fwd(Args args) {
    extern __shared__ __attribute__((aligned(16))) unsigned char lds_raw[];
    LAS unsigned char* lds = (LAS unsigned char*)lds_raw;
    volatile LAS unsigned* MISC = (volatile LAS unsigned*)(lds + MISC_OFF);
    const int tid = threadIdx.x, lane = tid & 63, wid = __builtin_amdgcn_readfirstlane(tid >> 6);
    const int G = gridDim.x, bx = blockIdx.x; const int vcu = (G % 8 == 0) ? (bx % 8) * (G / 8) + bx / 8 : bx;
    unsigned char* ws = args.ws; unsigned* ctl = (unsigned*)(ws + WS_CTL);
    const float* x = args.in[0]; const float* memx = args.in[1];
    const float *g_mix_pre = args.in[2], *g_mix_post = args.in[3], *g_ffn_pre = args.in[4], *g_ffn_post = args.in[5], *g_mem = args.in[6];
    const float *w_in = args.in[7], *rel_bias = args.in[8], *sinks = args.in[9], *w_mem_kv = args.in[10];
    const float *w_br_mb = args.in[11], *w_br_sw = args.in[12], *w_br_me = args.in[13], *w_out = args.in[14], *w_up = args.in[15];
    const float *conv_w = args.in[16], *conv_b = args.in[17], *w_down = args.in[18];
    float* out = args.out;
    bf16_t *Win_t = (bf16_t*)(ws + WS_WIN), *Wmkv_t = (bf16_t*)(ws + WS_WMEMKV), *Wbr_t = (bf16_t*)(ws + WS_WBR), *Wout_t = (bf16_t*)(ws + WS_WOUT), *Wup_t = (bf16_t*)(ws + WS_WUP), *Wdown_t = (bf16_t*)(ws + WS_WDOWN);
    bf16_t *HM = (bf16_t*)(ws + WS_HM), *MEMKV = (bf16_t*)(ws + WS_MEMKV), *H = (bf16_t*)(ws + WS_H), *PROJ = (bf16_t*)(ws + WS_PROJ), *OCAT = (bf16_t*)out, *MERGED = (bf16_t*)(ws + WS_H), *H2 = (bf16_t*)(ws + WS_H), *ACT = (bf16_t*)(ws + WS_ACT), *EDGE = (bf16_t*)(ws + WS_EDGE);
    float *tab = (float*)(ws + WS_TAB), *convp = tab + 2048, *kmean = (float*)(ws + WS_KMEAN), *Y1 = (float*)(ws + WS_Y1), *Y2 = (float*)(ws + WS_Y2), *X1 = out;
    unsigned *LCNT = (unsigned*)(ws + WS_LCNT), *CNT = (unsigned*)(ws + WS_CNT);
    bf16_t *PO01 = (bf16_t*)(ws + WS_PO01), *PO2 = (bf16_t*)(ws + WS_PO2); float* PL = (float*)((unsigned char*)out + DO_PL); unsigned short* SEG = (unsigned short*)((unsigned char*)out + DO_SEG);

    for (int u = tid; u < (LDS_BYTES - LDSCTL_OFF) / 4; u += NWAVES * 64) ((LAS unsigned*)(lds + LDSCTL_OFF))[u] = 0u;
    __syncthreads();
    XcdBarrier bar = xcd_barrier_post((unsigned*)(ctl + CW_BAR) + args.li * XCD_BAR_WORDS, MISC + 8);
    const int lo = args.ph_lo, hi_ph = args.ph_hi;
#define IN(k) (lo <= (k) && (k) < hi_ph)
#define SEAM(k) do { if (IN(k) && IN((k) + 1)) xcd_barrier(bar); } while (0)
    const int gw = vcu * NWAVES + wid, NGW = G * NWAVES;
    const int gt = vcu * (NWAVES * 64) + tid, NGT = G * NWAVES * 64;

    if (IN(0)) {
        LAS float* scr = (LAS float*)(lds + wid * 16384);
        constexpr int I_IN = (D / 64) * (INW / 32), I_MKV = (D / 64) * (1024 / 32), I_BR = (512 / 64) * (D / 32), I_OUT = (D / 64) * (D / 32), I_UP = (D / 64) * (UPW / 32), I_DN = (FF / 64) * (D / 32);
        constexpr int NITEMS = I_IN + I_MKV + 3 * I_BR + I_OUT + I_UP + I_DN;
        for (int it = gw; it < NITEMS; it += NGW) { int r = it;
            if (r < I_IN) { p0_transpose_item<0>(w_in, D, INW, Win_t, D, 0, scr, r, lane); continue; } r -= I_IN;
            if (r < I_MKV) { p0_transpose_item<0>(w_mem_kv, D, 1024, Wmkv_t, D, 0, scr, r, lane); continue; } r -= I_MKV;
            if (r < I_BR) { p0_transpose_item<0>(w_br_mb, 512, D, Wbr_t, 1536, 0, scr, r, lane); continue; } r -= I_BR;
            if (r < I_BR) { p0_transpose_item<0>(w_br_sw, 512, D, Wbr_t, 1536, 512, scr, r, lane); continue; } r -= I_BR;
            if (r < I_BR) { p0_transpose_item<0>(w_br_me, 512, D, Wbr_t, 1536, 1024, scr, r, lane); continue; } r -= I_BR;
            if (r < I_OUT) { p0_transpose_item<0>(w_out, D, D, Wout_t, D, 0, scr, r, lane); continue; } r -= I_OUT;
            if (r < I_UP) { p0_transpose_item<1>(w_up, D, UPW, Wup_t, D, 0, scr, r, lane); continue; } r -= I_UP;
            p0_transpose_item<0>(w_down, FF, D, Wdown_t, FF, 0, scr, r, lane); }
        for (int m = gw; m < T; m += NGW) rms_row_bf16(x + (size_t)m * D, g_mix_pre, H + (size_t)m * D, lane);
        for (int m = gw; m < MROWS; m += NGW) rms_row_bf16(memx + (size_t)m * D, g_mem, HM + (size_t)m * D, lane);
        for (int i = gt; i < UPW; i += NGT) {
            if (i < 16 * 128) { const int h = i >> 7, d = i & 127; tab[i] = rel_bias[t5_bucket(d) * 16 + h] * LOG2E; }
            const int isv = i >= FF, ch = isv ? i - FF : i, col = 256 * (ch >> 7) + 128 * isv + (ch & 127);
            convp[0 * UPW + col] = conv_w[0 * UPW + i]; convp[1 * UPW + col] = conv_w[1 * UPW + i]; convp[2 * UPW + col] = conv_w[2 * UPW + i]; convp[3 * UPW + col] = conv_b[i]; }
    }
    SEAM(0);
    if (IN(1)) {
        { pg8::Gemm g{HM, Wmkv_t, D, D, D}; pg8::FewOrder S{4, 16, 128, bx}; pg8::EpiBf16 E{MEMKV, 1024}; pg8::gemm_phase(lds, g, S, E); }
        { pg8::Gemm g{H, Win_t, D, D, D}; pg8::StaticOrder S; S.init(T, INW, G, bx); pg8::EpiProj E{PROJ, kmean}; pg8::gemm_phase(lds, g, S, E); }
    }
    SEAM(1);
    if (IN(2)) {
        for (int i = tid; i < 2048; i += NWAVES * 64) ((LAS float*)(lds + att::L_TAB))[i] = tab[i];
        __syncthreads();
        for (int uidx = vcu; uidx < 32 * NBLK; uidx += G) {
            const int bh = uidx >> 5, c = uidx & 31, b = bh >> 3, h = bh & 7;
            LAS float* km = (LAS float*)(lds + att::L_MISC);
            LAS float* candv = (LAS float*)(lds + att::L_MISC + 8192);
            LAS int* candi = (LAS int*)(lds + att::L_MISC + 8192 + 3072);
            LAS unsigned* selw = (LAS unsigned*)(lds + att::L_MISC + 8192 + 6144);
            for (int i = tid; i < c * 64; i += NWAVES * 64) km[i] = kmean[((size_t)bh * NBLK) * 64 + i];
            __syncthreads();
            const int q = tid & 255, half = tid >> 8; const int trow = b * SEQ + c * MBLK + q;
            float v0 = -INFINITY, v1 = -INFINITY, v2 = -INFINITY; int i0 = -1, i1 = -1, i2 = -1;
            { const bf16_t* qp = PROJ + (size_t)trow * INW + C_QMB + h * 64; float qv[64];
#pragma unroll
              for (int j = 0; j < 8; ++j) { const u32x4 w = *(const u32x4*)(qp + 8 * j);
#pragma unroll
                  for (int e = 0; e < 4; ++e) { qv[8 * j + 2 * e] = __builtin_bit_cast(float, w[e] << 16); qv[8 * j + 2 * e + 1] = __builtin_bit_cast(float, w[e] & 0xffff0000u); } }
              const int n_lo = half * 16, n_hi = (n_lo + 16 < c) ? n_lo + 16 : c;
              for (int n = n_lo; n < n_hi; ++n) { const LAS float* kp = km + n * 64; float a = 0.f;
#pragma unroll
                  for (int d = 0; d < 64; ++d) a += qv[d] * kp[d];
                  if (a > v0) { v2 = v1; i2 = i1; v1 = v0; i1 = i0; v0 = a; i0 = n; } else if (a > v1) { v2 = v1; i2 = i1; v1 = a; i1 = n; } else if (a > v2) { v2 = a; i2 = n; } } }
            if (half == 1) { candv[q * 3] = v0; candv[q * 3 + 1] = v1; candv[q * 3 + 2] = v2; candi[q * 3] = i0; candi[q * 3 + 1] = i1; candi[q * 3 + 2] = i2; }
            __syncthreads();
            if (half == 0) {
#pragma unroll
                for (int k = 0; k < 3; ++k) { const float a = candv[q * 3 + k]; const int n = candi[q * 3 + k];
                    if (n >= 0) { if (a > v0) { v2 = v1; i2 = i1; v1 = v0; i1 = i0; v0 = a; i0 = n; } else if (a > v1) { v2 = v1; i2 = i1; v1 = a; i1 = n; } else if (a > v2) { v2 = a; i2 = n; } } }
                selw[q] = (unsigned)(i0 & 0xff) | ((unsigned)(i1 & 0xff) << 8) | ((unsigned)(i2 & 0xff) << 16);
            }
            __syncthreads();
            for (int n = wid; n < c; n += NWAVES) { unsigned base = 0; unsigned short* sg = SEG + ((size_t)(bh * NBLK + c) * NBLK + n) * 256;
                for (int ch = 0; ch < 4; ++ch) { const unsigned s = selw[ch * 64 + lane]; const int r = ((s & 0xff) == (unsigned)n) ? 0 : (((s >> 8) & 0xff) == (unsigned)n) ? 1 : (((s >> 16) & 0xff) == (unsigned)n) ? 2 : -1;
                    const unsigned long long bal = __ballot(r >= 0); const unsigned pos = base + (unsigned)__builtin_popcountll(bal & ((1ull << lane) - 1ull));
                    if (r >= 0) sg[pos] = (unsigned short)((r << 8) | (ch * 64 + lane)); base += (unsigned)__builtin_popcountll(bal); }
                if (lane == 0) { CNT[(size_t)(bh * NBLK + c) * NBLK + n] = base; atomicAdd(&LCNT[bh * NBLK + n], base); } }
            __syncthreads();
        }
        for (int uidx = vcu; uidx < BATCH * 2 * 64 * 2; uidx += G) {
            const int hp = uidx & 1, nb = (uidx >> 1) & 63, kvh = (uidx >> 7) & 1, b = uidx >> 8;
            const int head = 4 * kvh + 2 * hp + (wid >> 2), wq = wid & 3, r32 = lane & 31, hi = lane >> 5;
            const int spos = nb * 128 + 32 * wq + r32; const size_t trow = (size_t)b * SEQ + spos;
            const int k0pos = (nb - 1) * 128;
            att::State<64> st; const float sink = sinks[head] * LOG2E; att::init_state<64>(st, sink, hi == 0 ? 1.0f : 0.0f);
            att::MkDistBias<true> mk{(const LAS float*)(lds + att::L_TAB) + (8 + head) * 128, spos - k0pos, hi};
            const unsigned need = (wq < 2) ? 0x7u : 0xeu; const int t_lo = (nb == 0) ? 2 : 0;
            const bf16_t* kt0 = PROJ + ((size_t)b * SEQ + k0pos) * INW + C_KSW + kvh * 64; const bf16_t* vt0 = PROJ + ((size_t)b * SEQ + k0pos) * INW + C_VSW + kvh * 64;
            att::run_tiles<64>(st, lds, PROJ + trow * INW + C_QSW + head * 64, kt0, vt0, (size_t)INW, t_lo, 4, need, mk, wid, lane);
            const float ltot = st.l + __shfl_xor(st.l, 32);
            att::store_rows<64>(st, ltot, OCAT + trow * 1536 + 512 + head * 64, true, hi);
        }
        for (int uidx = vcu; uidx < BATCH * 4 * 32; uidx += G) {
            const int qt = uidx & 31, mh = (uidx >> 5) & 3, b = uidx >> 7; const int r32 = lane & 31, hi = lane >> 5;
            const size_t trow = (size_t)b * SEQ + qt * 256 + 32 * wid + r32;
            att::State<128> st; att::init_state<128>(st, -3.0e38f, 0.f);
            const bf16_t* kt0 = MEMKV + (size_t)b * MEMLEN * 1024 + mh * 128; const bf16_t* vt0 = kt0 + 512;
            att::run_tiles<128>(st, lds, PROJ + trow * INW + C_QME + mh * 128, kt0, vt0, (size_t)1024, 0, 4, 0xfu, att::MkNoBias{}, wid, lane);
            const float ltot = st.l + __shfl_xor(st.l, 32);
            att::store_rows<128>(st, ltot, OCAT + trow * 1536 + 1024 + mh * 128, true, hi);
        }
    }
    SEAM(2);
    if (IN(3)) {
        LAS unsigned* pre = (LAS unsigned*)(lds + att::L_MISC);
        LAS unsigned* cpre = (LAS unsigned*)(lds + att::L_MISC + 8192);
        for (int i = tid; i < 2048; i += NWAVES * 64) ((LAS float*)(lds + att::L_TAB))[i] = tab[i];
        if (tid < 64) {
            unsigned v[16], s = 0;
#pragma unroll
            for (int j = 0; j < 16; ++j) { const unsigned L = LCNT[tid * 16 + j]; v[j] = 1u + (L + 255u) / 256u; s += v[j]; }
            unsigned inc = s;
#pragma unroll
            for (int o = 1; o < 64; o <<= 1) { const unsigned t = __shfl_up(inc, o); if (tid >= o) inc += t; }
            unsigned run = inc - s;
#pragma unroll
            for (int j = 0; j < 16; ++j) { pre[tid * 16 + j] = run; run += v[j]; }
            if (tid == 63) pre[1024] = run;
        }
        __syncthreads();
        const unsigned U = pre[1024];
        for (unsigned uidx = (unsigned)bx; uidx < U; uidx += (unsigned)G) {
            int loi = 0, hii = 1024;
            while (hii - loi > 1) { const int mid = (loi + hii) >> 1; if (pre[mid] <= uidx) loi = mid; else hii = mid; }
            const int bh = loi >> 5, n = loi & 31, j = (int)(uidx - pre[loi]), b = bh >> 3, h = bh & 7;
            const int r32 = lane & 31, hi = lane >> 5;
            int spos; int rank = 3; bool valid = true;
            if (j == 0) { spos = n * MBLK + 32 * wid + r32; }
            else {
                if (tid < 64) { const unsigned cv = (tid > n && tid < 32) ? CNT[(size_t)(bh * NBLK + tid) * NBLK + n] : 0u; unsigned inc = cv;
#pragma unroll
                    for (int o = 1; o < 32; o <<= 1) { const unsigned t = __shfl_up(inc, o); if (tid >= o) inc += t; }
                    if (tid < 32) cpre[tid + 1] = inc; if (tid == 0) cpre[0] = 0u; }
                __syncthreads();
                const unsigned p = (unsigned)(256 * (j - 1) + 32 * wid + r32); valid = p < cpre[32];
                int c = n + 1; if (valid) { while (cpre[c + 1] <= p) ++c; }
                unsigned e = 0; if (valid) e = SEG[((size_t)(bh * NBLK + c) * NBLK + n) * 256 + (p - cpre[c])];
                rank = valid ? (int)(e >> 8) : 0; spos = valid ? c * MBLK + (int)(e & 255u) : n * MBLK + MBLK;
            }
            const size_t trow = (size_t)b * SEQ + spos;
            att::State<64> st; att::init_state<64>(st, -3.0e38f, 0.f);
            att::MkDistBias<false> mk{(const LAS float*)(lds + att::L_TAB) + h * 128, spos - n * MBLK, hi};
            const unsigned need = (j == 0) ? ((2u << (wid >> 1)) - 1u) : 0xfu;
            const bf16_t* kt0 = PROJ + ((size_t)b * SEQ + n * MBLK) * INW + C_KMB + h * 64; const bf16_t* vt0 = PROJ + ((size_t)b * SEQ + n * MBLK) * INW + C_VMB + h * 64;
            att::run_tiles<64>(st, lds, PROJ + trow * INW + C_QMB + h * 64, kt0, vt0, (size_t)INW, 0, 4, need, mk, wid, lane);
            const float ltot = st.l + __shfl_xor(st.l, 32);
            bf16_t* orow = (rank == 3) ? OCAT + trow * 1536 + h * 64 : (rank == 2 ? PO2 : PO01 + (size_t)rank * T * 512) + (trow * 8 + h) * 64;
            att::store_rows<64>(st, ltot, orow, valid, hi);
            if (valid && hi == 0) PL[((size_t)rank * T + trow) * 8 + h] = st.m + log2f(ltot);
        }
    }
    SEAM(3);
    if (IN(4)) {
        for (int i = gt; i < T * 8 * 8; i += NGT) { const int ch = i & 7, h = (i >> 3) & 7, t = i >> 6; const int c = (t % SEQ) / MBLK, nsel = c < 3 ? c : 3;
            const size_t th = (size_t)t * 8 + h;
            float ls[4]; ls[3] = PL[(size_t)3 * T * 8 + th]; float M = ls[3];
#pragma unroll
            for (int r = 0; r < 3; ++r) { ls[r] = (r < nsel) ? PL[(size_t)r * T * 8 + th] : -INFINITY; M = fmaxf(M, ls[r]); }
            float wsum = 0.f, acc[8] = {0.f, 0.f, 0.f, 0.f, 0.f, 0.f, 0.f, 0.f};
#pragma unroll
            for (int r = 0; r < 4; ++r) { if (r < 3 && r >= nsel) continue; const float w = fast_exp2(ls[r] - M); wsum += w;
                const bf16_t* src = (r == 3) ? OCAT + (size_t)t * 1536 + h * 64 + ch * 8 : (r == 2 ? PO2 : PO01 + (size_t)r * T * 512) + th * 64 + ch * 8;
                const u32x4 v = *(const u32x4*)src;
#pragma unroll
                for (int e = 0; e < 4; ++e) { acc[2 * e] += w * __builtin_bit_cast(float, v[e] << 16); acc[2 * e + 1] += w * __builtin_bit_cast(float, v[e] & 0xffff0000u); } }
            const float inv = 1.0f / wsum; u32x4 o;
#pragma unroll
            for (int e = 0; e < 4; ++e) o[e] = cvt_pk_bf16(acc[2 * e] * inv, acc[2 * e + 1] * inv);
            *(u32x4*)(OCAT + (size_t)t * 1536 + h * 64 + ch * 8) = o; }
    }
    SEAM(4);
    if (IN(5)) { pg8::Gemm g{OCAT, Wbr_t, 1536, 1536, 512}; pg8::SubOrder3 S; S.init(T, D, G, bx); pg8::EpiBranch E{PROJ, MERGED}; pg8::gemm_phase(lds, g, S, E); }
    SEAM(5);
    if (IN(6)) { pg8::Gemm g{MERGED, Wout_t, D, D, D}; pg8::StaticOrder S; S.init(T, D, G, bx); pg8::EpiF32 E{Y1, D}; pg8::gemm_phase(lds, g, S, E); }
    SEAM(6);
    if (IN(7)) {
        for (int row = gw; row < T; row += NGW) {
            const f32x4* yr = (const f32x4*)(Y1 + (size_t)row * D) + lane; const f32x4* xr = (const f32x4*)(x + (size_t)row * D) + lane;
            f32x4 v[4]; float s = 0.f;
#pragma unroll
            for (int j = 0; j < 4; ++j) { v[j] = yr[64 * j]; s += v[j].x * v[j].x + v[j].y * v[j].y + v[j].z * v[j].z + v[j].w * v[j].w; }
            const float r = rsqrtf(wave_sum(s) * (1.0f / D) + RMS_EPS); float s2 = 0.f;
#pragma unroll
            for (int j = 0; j < 4; ++j) { const f32x4 gg = ((const f32x4*)g_mix_post)[lane + 64 * j]; v[j] = xr[64 * j] + v[j] * r * gg; s2 += v[j].x * v[j].x + v[j].y * v[j].y + v[j].z * v[j].z + v[j].w * v[j].w;
                ((f32x4*)(X1 + (size_t)row * D))[lane + 64 * j] = v[j]; }
            const float r2 = rsqrtf(wave_sum(s2) * (1.0f / D) + RMS_EPS);
#pragma unroll
            for (int j = 0; j < 4; ++j) { const f32x4 gg = ((const f32x4*)g_ffn_pre)[lane + 64 * j]; ((unsigned long long*)(H2 + (size_t)row * D))[lane + 64 * j] = pack4bf(v[j].x * r2 * gg.x, v[j].y * r2 * gg.y, v[j].z * r2 * gg.z, v[j].w * r2 * gg.w); }
        }
    }
    SEAM(7);
    if (IN(8)) { pg8::Gemm g{H2, Wup_t, D, D, D}; pg8::StaticOrder S; S.init(T, UPW, G, bx); pg8::EpiUp E{ACT, EDGE, convp}; pg8::gemm_phase(lds, g, S, E); }
    SEAM(8);
    if (IN(9)) {
        for (int i = gt; i < (T / 64) * 2 * (FF / 8); i += NGT) { const int c8 = i % (FF / 8), e = (i / (FF / 8)) & 1, g64 = i / (2 * (FF / 8));
            const int ch0 = c8 * 8, tcol = 256 * (ch0 >> 7) + (ch0 & 127); const bool first = (g64 % (SEQ / 64)) == 0;
            const bf16_t* cur = EDGE + ((size_t)g64 * 4 + e) * UPW + tcol;
            const bf16_t* p1 = (e == 1) ? EDGE + ((size_t)g64 * 4 + 0) * UPW + tcol : EDGE + ((size_t)(g64 - 1) * 4 + 3) * UPW + tcol;
            const bf16_t* p2 = (e == 1) ? EDGE + ((size_t)(g64 - 1) * 4 + 3) * UPW + tcol : EDGE + ((size_t)(g64 - 1) * 4 + 2) * UPW + tcol;
            const bool z1 = first && e == 0, z2 = first;
            u32x4 o;
#pragma unroll
            for (int hv = 0; hv < 2; ++hv) {
                float ug[4], uv[4];
#pragma unroll
                for (int gv = 0; gv < 2; ++gv) { const int off = gv * 128 + hv * 4; const float* cp = convp + tcol + off;
                    const f32x4 w0 = *(const f32x4*)cp, w1 = *(const f32x4*)(cp + UPW), w2 = *(const f32x4*)(cp + 2 * UPW), wb = *(const f32x4*)(cp + 3 * UPW);
                    const u32x2 c = *(const u32x2*)(cur + off); u32x2 a = {0u, 0u}, bb = {0u, 0u}; if (!z1) a = *(const u32x2*)(p1 + off); if (!z2) bb = *(const u32x2*)(p2 + off);
#pragma unroll
                    for (int k = 0; k < 4; ++k) { const unsigned cw = c[k >> 1], aw = a[k >> 1], bw = bb[k >> 1];
                        const float fc = __builtin_bit_cast(float, (k & 1) ? (cw & 0xffff0000u) : (cw << 16)), fa = __builtin_bit_cast(float, (k & 1) ? (aw & 0xffff0000u) : (aw << 16)), fb = __builtin_bit_cast(float, (k & 1) ? (bw & 0xffff0000u) : (bw << 16));
                        const float uu = wb[k] + w2[k] * fc + w1[k] * fa + w0[k] * fb; if (gv == 0) ug[k] = uu; else uv[k] = uu; } }
                o[2 * hv] = cvt_pk_bf16(fast_gelu(ug[0]) * uv[0], fast_gelu(ug[1]) * uv[1]); o[2 * hv + 1] = cvt_pk_bf16(fast_gelu(ug[2]) * uv[2], fast_gelu(ug[3]) * uv[3]); }
            *(u32x4*)(ACT + (size_t)(g64 * 64 + e) * FF + ch0) = o; }
    }
    SEAM(9);
    if (IN(10)) { pg8::Gemm g{ACT, Wdown_t, FF, FF, FF}; pg8::StaticOrder S; S.init(T, D, G, bx); pg8::EpiF32 E{Y2, D}; pg8::gemm_phase(lds, g, S, E); }
    SEAM(10);
    if (IN(11)) {
        const bool poison = __hip_atomic_load((unsigned*)(ctl + CW_BAR) + args.li * XCD_BAR_WORDS + XB_TMO, __ATOMIC_RELAXED, __HIP_MEMORY_SCOPE_AGENT) != 0u;
        for (int row = gw; row < T; row += NGW) {
            const f32x4* yr = (const f32x4*)(Y2 + (size_t)row * D) + lane; f32x4* xr = (f32x4*)(out + (size_t)row * D) + lane;
            f32x4 v[4]; float s = 0.f;
#pragma unroll
            for (int j = 0; j < 4; ++j) { v[j] = yr[64 * j]; s += v[j].x * v[j].x + v[j].y * v[j].y + v[j].z * v[j].z + v[j].w * v[j].w; }
            float r = rsqrtf(wave_sum(s) * (1.0f / D) + RMS_EPS); if (poison) r = __builtin_nanf("");
#pragma unroll
            for (int j = 0; j < 4; ++j) { const f32x4 gg = ((const f32x4*)g_ffn_post)[lane + 64 * j]; xr[64 * j] = xr[64 * j] + v[j] * r * gg; }
        }
    }
#undef IN
#undef SEAM
}
#ifndef MEGA_LO
#define MEGA_LO 0
#endif
#ifndef MEGA_HI
#define MEGA_HI NPHASE
#endif
extern "C" void kernel_launch(void* const* d_in, const int* in_sizes, int n_in, void* d_out, int out_size, void* d_ws, size_t ws_size, hipStream_t stream) {
    if (n_in != 19 || in_sizes[0] != T * D || out_size != T * D || ws_size < WS_END) { fprintf(stderr, "kernel_launch: unexpected shapes / workspace (n_in %d, ws %zu)\n", n_in, ws_size); return; }
    static int grid = 0;
    if (grid == 0) {
        int dev = 0, cus = 0, per_cu = 0;
        if (hipGetDevice(&dev) != hipSuccess || hipDeviceGetAttribute(&cus, hipDeviceAttributeMultiprocessorCount, dev) != hipSuccess) { fprintf(stderr, "kernel_launch: device query failed\n"); grid = -1; return; }
        if (hipFuncSetAttribute((const void*)mega_fwd, hipFuncAttributeMaxDynamicSharedMemorySize, LDS_BYTES) != hipSuccess) { fprintf(stderr, "kernel_launch: hipFuncSetAttribute failed\n"); grid = -1; return; }
        if (hipOccupancyMaxActiveBlocksPerMultiprocessor(&per_cu, (const void*)mega_fwd, NWAVES * 64, LDS_BYTES) != hipSuccess || per_cu < 1) { fprintf(stderr, "kernel_launch: occupancy query says %d blocks per CU\n", per_cu); (void)hipGetLastError(); grid = -1; return; }
        grid = cus;
    }
    if (grid < 0) return;
    const float* x = (const float*)d_in[0]; const float* mem = (const float*)d_in[1];
    const float *g_mix_pre = (const float*)d_in[2], *g_mix_post = (const float*)d_in[3], *g_ffn_pre = (const float*)d_in[4], *g_ffn_post = (const float*)d_in[5], *g_mem = (const float*)d_in[6];
    const float *w_in = (const float*)d_in[7], *rel_bias = (const float*)d_in[8], *sinks = (const float*)d_in[9], *w_mem_kv = (const float*)d_in[10];
    const float *w_br_mb = (const float*)d_in[11], *w_br_sw = (const float*)d_in[12], *w_br_me = (const float*)d_in[13], *w_out = (const float*)d_in[14], *w_up = (const float*)d_in[15];
    const float *conv_w = (const float*)d_in[16], *conv_b = (const float*)d_in[17], *w_down = (const float*)d_in[18];
    unsigned char* ws = (unsigned char*)d_ws; float* out = (float*)d_out;
    bf16_t *Win_t = (bf16_t*)(ws + WS_WIN), *Wmkv_t = (bf16_t*)(ws + WS_WMEMKV), *Wbr_t = (bf16_t*)(ws + WS_WBR), *Wout_t = (bf16_t*)(ws + WS_WOUT), *Wup_t = (bf16_t*)(ws + WS_WUP), *Wdown_t = (bf16_t*)(ws + WS_WDOWN);
    bf16_t *HM = (bf16_t*)(ws + WS_HM), *MEMKV = (bf16_t*)(ws + WS_MEMKV), *H = (bf16_t*)(ws + WS_H), *PROJ = (bf16_t*)(ws + WS_PROJ), *OCAT = (bf16_t*)d_out, *MERGED = (bf16_t*)(ws + WS_H), *H2 = (bf16_t*)(ws + WS_H), *ACT = (bf16_t*)(ws + WS_ACT);
    float *tab = (float*)(ws + WS_TAB), *kmean = (float*)(ws + WS_KMEAN), *Y1 = (float*)(ws + WS_Y1), *Y2 = (float*)(ws + WS_Y2), *X1 = out;
    (void)hipMemsetAsync(ws + WS_CTL, 0, CTL_ZERO_BYTES, stream);
    bool mega_done = false;
    for (int ph = 0; ph < NPHASE; ++ph) {
        if (ph >= MEGA_LO && ph < MEGA_HI) {
            if (!mega_done) { Args a{}; for (int i = 0; i < 19; ++i) a.in[i] = (const float*)d_in[i]; a.out = out; a.ws = ws; a.ph_lo = MEGA_LO; a.ph_hi = MEGA_HI; a.li = 0; a.pad = 0;
                hipLaunchKernelGGL(mega_fwd, dim3(grid), dim3(NWAVES * 64), LDS_BYTES, stream, a); mega_done = true; }
            continue; }
        switch (ph) {
        case 0:
            k_transpose<0><<<dim3(INW / 32, D / 32), 256, 0, stream>>>(w_in, D, INW, Win_t, D, 0);
            k_transpose<0><<<dim3(1024 / 32, D / 32), 256, 0, stream>>>(w_mem_kv, D, 1024, Wmkv_t, D, 0);
            k_transpose<0><<<dim3(D / 32, 512 / 32), 256, 0, stream>>>(w_br_mb, 512, D, Wbr_t, 1536, 0);
            k_transpose<0><<<dim3(D / 32, 512 / 32), 256, 0, stream>>>(w_br_sw, 512, D, Wbr_t, 1536, 512);
            k_transpose<0><<<dim3(D / 32, 512 / 32), 256, 0, stream>>>(w_br_me, 512, D, Wbr_t, 1536, 1024);
            k_transpose<0><<<dim3(D / 32, D / 32), 256, 0, stream>>>(w_out, D, D, Wout_t, D, 0);
            k_transpose<1><<<dim3(UPW / 32, D / 32), 256, 0, stream>>>(w_up, D, UPW, Wup_t, D, 0);
            k_transpose<0><<<dim3(D / 32, FF / 32), 256, 0, stream>>>(w_down, FF, D, Wdown_t, FF, 0);
            k_tables<<<(UPW + 255) / 256, 256, 0, stream>>>(rel_bias, conv_w, conv_b, tab);
            k_rmsnorm_bf16<<<T / 4, 256, 0, stream>>>(x, g_mix_pre, H, T);
            k_rmsnorm_bf16<<<MROWS / 4, 256, 0, stream>>>(mem, g_mem, HM, MROWS);
            break;
        case 1:
            k_gemm_simple<EpiProj><<<(T / 32) * (INW / 32) / 4, 256, 0, stream>>>(H, D, Win_t, D, T, INW, D, EpiProj{PROJ});
            k_kmean<<<BATCH * 8 * NBLK * 64 / 256, 256, 0, stream>>>(PROJ, kmean);
            k_gemm_simple<EpiBf><<<(MROWS / 32) * (1024 / 32) / 4, 256, 0, stream>>>(HM, D, Wmkv_t, D, MROWS, 1024, D, EpiBf{MEMKV, 1024});
            break;
        case 2:
            k_moba_naive<<<T * 8 / 4, 256, 0, stream>>>(PROJ, kmean, tab, OCAT);
            k_swa_naive<<<T * 8 / 4, 256, 0, stream>>>(PROJ, sinks, tab, OCAT);
            k_mem_naive<<<T * 4 / 4, 256, 0, stream>>>(PROJ, MEMKV, OCAT);
            break;
        case 5: k_branch_naive<<<(T / 32) * (D / 32) / 4, 256, 0, stream>>>(OCAT, Wbr_t, PROJ, MERGED); break;
        case 6: k_gemm_simple<EpiF><<<(T / 32) * (D / 32) / 4, 256, 0, stream>>>(MERGED, D, Wout_t, D, T, D, D, EpiF{Y1, D}); break;
        case 7: k_norm2<<<T / 4, 256, 0, stream>>>(x, Y1, g_mix_post, g_ffn_pre, X1, H2); break;
        case 8: k_up_naive<<<(T / 32) * (FF / 32) / 4, 256, 0, stream>>>(H2, Wup_t, tab + 2048, ACT); break;
        case 10: k_gemm_simple<EpiF><<<(T / 32) * (D / 32) / 4, 256, 0, stream>>>(ACT, FF, Wdown_t, FF, T, D, FF, EpiF{Y2, D}); break;
        case 11: k_final<<<T / 4, 256, 0, stream>>>(Y2, g_ffn_post, out); break;
        default: break;
        }
    }
}
```

```cpp
#include <hip/hip_runtime.h>
#include <cstdio>
#include <cstdint>

constexpr int BATCH = 4, SEQ = 8192, T = BATCH * SEQ, D = 1024;
constexpr int INW = 5888, FF = 2816, UPW = 2 * FF;
constexpr int PJW = 4608;
constexpr int C_QMB = 0, C_QSW = 512, C_QME = 1024, C_GMB = 1536;
constexpr int MEMLEN = 256, MROWS = BATCH * MEMLEN;
constexpr int NBLK = 32, MBLK = 256;
constexpr float LOG2E = 1.4426950408889634f;
constexpr float C2_64 = 0.125f * LOG2E;
constexpr float C2_128 = 0.08838834764831845f * LOG2E;
constexpr float RMS_EPS = 1e-6f;

constexpr size_t MiB = 1u << 20;
constexpr size_t WS_CTL = 0, CTL_ZERO_BYTES = 1 * MiB;
constexpr size_t WS_KMEAN = 512 * 1024;
constexpr size_t WS_WIN = 1 * MiB, WS_WMEMKV = 13 * MiB, WS_WBR = 15 * MiB, WS_WOUT = 18 * MiB, WS_WUP = 20 * MiB, WS_WDOWN = 31 * MiB;
constexpr size_t WS_HM = 37 * MiB, WS_MEMK = 39 * MiB, WS_MEMV = 40 * MiB, WS_TAB = 41 * MiB;
constexpr size_t WS_H = 44 * MiB;
constexpr size_t WS_PROJ = 108 * MiB;
constexpr size_t WS_KMB = 396 * MiB, WS_VMB = 428 * MiB, WS_KSW = 460 * MiB, WS_VSW = 468 * MiB;
constexpr size_t WS_Y1 = 108 * MiB, WS_ACT = 108 * MiB, WS_EDGE = 284 * MiB, WS_Y2 = 306 * MiB;
constexpr size_t WS_END = 512 * MiB;
typedef unsigned short bf16_t;
typedef short bf16x8 __attribute__((ext_vector_type(8)));
typedef float f32x4 __attribute__((ext_vector_type(4)));
typedef float f32x16 __attribute__((ext_vector_type(16)));
typedef unsigned u32x4 __attribute__((ext_vector_type(4)));

__device__ __forceinline__ unsigned f2bf(float f) { unsigned u = __builtin_bit_cast(unsigned, f); return (u + 0x7fffu + ((u >> 16) & 1u)) >> 16; }
__device__ __forceinline__ float wave_sum(float v) {
#pragma unroll
    for (int o = 1; o < 64; o <<= 1) v += __shfl_xor(v, o);
    return v;
}
__device__ __forceinline__ int t5_bucket(int dist) {
    const int n = dist < 0 ? 0 : dist;
    if (n < 16) return n;
    int large = 16 + (int)(logf((float)n / 16.0f) / logf(8.0f) * 16.0f);
    return large < 31 ? large : 31;
}

#define LAS __attribute__((address_space(3)))
#define GAS __attribute__((address_space(1)))
typedef float f32x2 __attribute__((ext_vector_type(2)));
typedef unsigned u32x2 __attribute__((ext_vector_type(2)));
typedef short s16x4 __attribute__((ext_vector_type(4)));
typedef __bf16 bf16x2_t __attribute__((ext_vector_type(2)));
__device__ __forceinline__ unsigned cvt_pk_bf16(float lo, float hi) { f32x2 v = {lo, hi}; bf16x2_t b = __builtin_convertvector(v, bf16x2_t); return __builtin_bit_cast(unsigned, b); }
__device__ __forceinline__ float fast_exp2(float x) { return __builtin_amdgcn_exp2f(x); }
__device__ __forceinline__ float fast_rcp(float x) { return __builtin_amdgcn_rcpf(x); }
__device__ __forceinline__ float fast_sigmoid(float x) { return fast_rcp(1.0f + fast_exp2(-LOG2E * x)); }
__device__ __forceinline__ float fast_gelu(float x) { const float x2 = x * x; const float t = x * (-2.302208198f - 0.102943234f * x2); return x * fast_rcp(1.0f + fast_exp2(t)); }

#ifdef PROBE_REGION
#define GPR_BEGIN(r) do { if ((r) == PROBE_REGION && PROBE_GEMM_PHASE == pr_phase) pr_t0 = __builtin_amdgcn_s_memrealtime(); } while (0)
#define GPR_END(r) do { if ((r) == PROBE_REGION && PROBE_GEMM_PHASE == pr_phase) pr_acc += __builtin_amdgcn_s_memrealtime() - pr_t0; } while (0)
#else
#define GPR_BEGIN(r) do {} while (0)
#define GPR_END(r) do {} while (0)
#endif
namespace pg8 {
constexpr int BM = 256, BK = 64, HALF = 128, HTB = HALF * BK * 2, STAGE_BYTES = 8 * HTB, NXCD = 8, WGM = 8;
__host__ __device__ __forceinline__ int lds_byte(int r, int c) { const int st = (r >> 4) * 2 + (c >> 5), rr = r & 15, cc = c & 31, ob = rr * 64 + cc * 2; return st * 1024 + (ob ^ (((ob >> 9) & 1) << 5)); }
__host__ __device__ __forceinline__ void stage_rc(int b, int& R, int& C) { const int st = b / 1024, sb = b % 1024, swz = sb ^ (((sb >> 9) & 1) << 5); R = (st >> 1) * 16 + swz / 64; C = (st & 1) * 32 + (swz % 64) / 2; }
__host__ __device__ __forceinline__ int perm32(int rho) { const int n = rho >> 4, i = rho & 15; return 8 * (i >> 2) + 4 * n + (i & 3); }

struct Unit { int pm, pn, sub; };
struct Gemm { const bf16_t* A; const bf16_t* Bt; int lda, ldb, K; };

struct StaticOrder {
    int nM, nN, nwg, G, c;
    __device__ void init(int M, int N, int G_, int c_) { nM = M / BM; nN = N / BM; nwg = nM * nN; G = G_; c = c_; }
    __device__ bool tile(long L, Unit& u) const {
        if (L >= nwg) return false;
        int wgid = (int)L; { const int q = nwg / NXCD, r = nwg % NXCD, xcd = wgid % NXCD, off = wgid / NXCD; wgid = (xcd < r ? xcd * (q + 1) : r * (q + 1) + (xcd - r) * q) + off; }
        const int nig = WGM * nN, gid = wgid / nig, fm = gid * WGM, gsz = (nM - fm) < WGM ? (nM - fm) : WGM;
        u.pm = fm + ((wgid % nig) % gsz); u.pn = (wgid % nig) / gsz; u.sub = 0; return true;
    }
    __device__ bool next(int i, Unit& u) const { return tile((long)i * G + c, u); }
};
struct SubOrder3 : StaticOrder {
    __device__ bool next(int i, Unit& u) const { const int t = i / 3; if (!tile((long)t * G + c, u)) return false; u.sub = i - 3 * t; return true; }
};
struct FewOrder {
    int nN, nu, c0, c;
    __device__ bool next(int i, Unit& u) const { const int k = c - c0; if (i > 0 || k < 0 || k >= nu) return false; u.pm = k / nN; u.pn = k % nN; u.sub = 0; return true; }
};
typedef f32x4 Acc[2][2][4][2];
__device__ __forceinline__ void zero_acc(Acc& acc) {
#pragma unroll
    for (int a = 0; a < 2; ++a)
#pragma unroll
        for (int b = 0; b < 2; ++b)
#pragma unroll
            for (int m = 0; m < 4; ++m)
#pragma unroll
                for (int n = 0; n < 2; ++n) acc[a][b][m][n] = (f32x4){0.f, 0.f, 0.f, 0.f};
}
template <class Epi, class Sched>
__device__ __forceinline__ void gemm_phase(LAS unsigned char* lds, const Gemm g, const Sched& S, const Epi& E, unsigned long long& pr_acc, int pr_phase) {
    unsigned long long pr_t0 = 0ull; (void)pr_t0; (void)pr_phase;
    const int tid = threadIdx.x, wid = __builtin_amdgcn_readfirstlane(tid >> 6), lane = tid & 63, wr = wid >> 2, wc = wid & 3, fr = lane & 15, fq = lane >> 4;
    const int K = g.K, nt = K / BK;
    unsigned voffA[2], voffB[2];
#pragma unroll
    for (int i = 0; i < 2; ++i) { int R, C; stage_rc(tid * 16 + i * 8192, R, C); const int Rb = Epi::PERM ? ((R & ~31) + perm32(R & 31)) : R;
        voffA[i] = (unsigned)(R * g.lda + C) * 2u; voffB[i] = (unsigned)(Rb * g.ldb + C) * 2u; }
    const size_t kstep = (size_t)(BK * 2);
    const size_t hstepA = (size_t)HALF * g.lda * 2, hstepB = (size_t)HALF * g.ldb * 2;
    const unsigned ldsw = (unsigned)wid * 1024u;
    const int aoff = lds_byte(wr * 64 + fr, fq * 8), boff = lds_byte(wc * 32 + fr, fq * 8);
#define PG8_UA(u) ((const char*)g.A + ((size_t)(u).pm * BM * g.lda + (size_t)(u).sub * K) * 2)
#define PG8_UB(u) ((const char*)g.Bt + ((size_t)(u).pn * BM * g.ldb + (size_t)(u).sub * K) * 2)
#define PG8_SA(b, h) (((b) * 2 + (h)) * HTB)
#define PG8_SB(b, h) ((4 + (b) * 2 + (h)) * HTB)
#define PG8_STAGE(bufoff, gbase, voff) do { _Pragma("unroll") for (int _i = 0; _i < 2; ++_i) \
        __builtin_amdgcn_global_load_lds((const unsigned*)((const char*)(gbase) + (voff)[_i]), (LAS unsigned*)(lds + (bufoff) + ldsw + _i * 8192), 16, 0, 0); } while (0)
#define PG8_LDA(dst, b, h) do { _Pragma("unroll") for (int m = 0; m < 4; ++m) _Pragma("unroll") for (int k = 0; k < 2; ++k) dst[m][k] = *(const LAS bf16x8*)(lds + PG8_SA(b, h) + aoff + m * 2048 + k * 1024); } while (0)
#define PG8_LDB(dst, b, h) do { _Pragma("unroll") for (int n = 0; n < 2; ++n) _Pragma("unroll") for (int k = 0; k < 2; ++k) dst[n][k] = *(const LAS bf16x8*)(lds + PG8_SB(b, h) + boff + n * 2048 + k * 1024); } while (0)
#define PG8_MMA(ai, bj, At, Bt) do { __builtin_amdgcn_s_setprio(1); _Pragma("unroll") for (int m = 0; m < 4; ++m) _Pragma("unroll") for (int n = 0; n < 2; ++n) _Pragma("unroll") for (int k = 0; k < 2; ++k) \
        acc[ai][bj][m][n] = __builtin_amdgcn_mfma_f32_16x16x32_bf16(Bt[n][k], At[m][k], acc[ai][bj][m][n], 0, 0, 0); __builtin_amdgcn_s_setprio(0); } while (0)
#define PG8_WAIT_V(n) asm volatile("s_waitcnt vmcnt(" #n ")" ::: "memory")
#define PG8_WAIT_L(n) asm volatile("s_waitcnt lgkmcnt(" #n ")" ::: "memory")
#define PG8_BAR __builtin_amdgcn_s_barrier()
#define PG8_SCHED __builtin_amdgcn_sched_barrier(0)
    Unit cur, nxt; int ui = 0;
    if (!S.next(0, cur)) return;
    Acc acc; zero_acc(acc);
    bf16x8 At[4][2], B0[2][2], B1[2][2];
    const char* cA = PG8_UA(cur); const char* cB = PG8_UB(cur);
    PG8_STAGE(PG8_SB(0, 0), cB, voffB); PG8_STAGE(PG8_SB(0, 1), cB + hstepB, voffB); PG8_STAGE(PG8_SA(0, 0), cA, voffA); PG8_STAGE(PG8_SA(0, 1), cA + hstepA, voffA);
    if (wr == 1) PG8_BAR;
    PG8_WAIT_V(2); PG8_BAR;
    PG8_STAGE(PG8_SB(1, 0), cB + kstep, voffB); PG8_STAGE(PG8_SA(1, 0), cA + kstep, voffA); PG8_STAGE(PG8_SB(1, 1), cB + hstepB + kstep, voffB);
    PG8_WAIT_V(6); PG8_BAR;
    for (;;) {
        const bool has_next = S.next(ui + 1, nxt);
        const char* nA = has_next ? PG8_UA(nxt) : cA; const char* nB = has_next ? PG8_UB(nxt) : cB;
        GPR_BEGIN(6);
        for (int t = 0; t < nt; t += 2) {
            const bool last = (t == nt - 2);
            const char* a1 = cA + (size_t)(t + 1) * kstep;
            const char* a2 = last ? nA : cA + (size_t)(t + 2) * kstep; const char* b2 = last ? nB : cB + (size_t)(t + 2) * kstep;
            const char* a3 = a2 + kstep; const char* b3 = b2 + kstep;
            PG8_LDB(B0, 0, 0); PG8_LDB(B1, 0, 1); PG8_SCHED; PG8_LDA(At, 0, 0); PG8_STAGE(PG8_SA(1, 1), a1 + hstepA, voffA);
            PG8_WAIT_V(8); PG8_WAIT_L(0); PG8_BAR; PG8_MMA(0, 0, At, B0); PG8_MMA(0, 1, At, B1); PG8_BAR; PG8_SCHED;
            PG8_LDA(At, 0, 1); PG8_STAGE(PG8_SB(0, 0), b2, voffB); PG8_STAGE(PG8_SB(0, 1), b2 + hstepB, voffB); PG8_STAGE(PG8_SA(0, 0), a2, voffA);
            PG8_WAIT_V(8); PG8_WAIT_L(0); PG8_BAR; PG8_MMA(1, 0, At, B0); PG8_MMA(1, 1, At, B1); PG8_BAR; PG8_SCHED;
            PG8_LDB(B0, 1, 0); PG8_LDB(B1, 1, 1); PG8_SCHED; PG8_LDA(At, 1, 0); PG8_STAGE(PG8_SA(0, 1), a2 + hstepA, voffA);
            PG8_WAIT_V(8); PG8_WAIT_L(0); PG8_BAR; PG8_MMA(0, 0, At, B0); PG8_MMA(0, 1, At, B1); PG8_BAR; PG8_SCHED;
            PG8_LDA(At, 1, 1); PG8_STAGE(PG8_SB(1, 0), b3, voffB); PG8_STAGE(PG8_SB(1, 1), b3 + hstepB, voffB); PG8_STAGE(PG8_SA(1, 0), a3, voffA);
            PG8_WAIT_V(8); PG8_WAIT_L(0); PG8_BAR; PG8_MMA(1, 0, At, B0); PG8_MMA(1, 1, At, B1); PG8_BAR; PG8_SCHED;
        }
        if (wr == 0) PG8_BAR;
        GPR_END(6); GPR_BEGIN(7);
        E(acc, cur, wr, wc, fr, fq);
        GPR_END(7);
        if (!has_next) break;
        cur = nxt; cA = nA; cB = nB; ++ui;
        if (wr == 1) PG8_BAR;
    }
    PG8_WAIT_V(0);
    PG8_BAR;
#undef PG8_UA
#undef PG8_UB
#undef PG8_SA
#undef PG8_SB
#undef PG8_STAGE
#undef PG8_LDA
#undef PG8_LDB
#undef PG8_MMA
#undef PG8_WAIT_V
#undef PG8_WAIT_L
#undef PG8_BAR
#undef PG8_SCHED
}

struct EpiF32 { static constexpr bool PERM = false; float* C; int ldc;
    __device__ __forceinline__ void operator()(Acc& acc, const Unit& u, int wr, int wc, int fr, int fq) const {
        const int row0 = u.pm * BM + wr * 64 + fr, col0 = u.pn * BM + wc * 32 + 4 * fq;
#pragma unroll
        for (int ai = 0; ai < 2; ++ai)
#pragma unroll
            for (int m = 0; m < 4; ++m) { float* rowp = C + (size_t)(row0 + ai * HALF + m * 16) * ldc + col0;
#pragma unroll
                for (int bj = 0; bj < 2; ++bj)
#pragma unroll
                    for (int n = 0; n < 2; ++n) *(f32x4*)(rowp + bj * HALF + n * 16) = acc[ai][bj][m][n]; }
        zero_acc(acc);
    } };
struct EpiBf16 { static constexpr bool PERM = true; bf16_t* O; int ldc;
    __device__ __forceinline__ void operator()(Acc& acc, const Unit& u, int wr, int wc, int fr, int fq) const {
        const int row0 = u.pm * BM + wr * 64 + fr, col0 = u.pn * BM + wc * 32 + 8 * fq;
#pragma unroll
        for (int ai = 0; ai < 2; ++ai)
#pragma unroll
            for (int m = 0; m < 4; ++m) { bf16_t* rowp = O + (size_t)(row0 + ai * HALF + m * 16) * ldc + col0;
#pragma unroll
                for (int bj = 0; bj < 2; ++bj) { const f32x4 v0 = acc[ai][bj][m][0], v1 = acc[ai][bj][m][1];
                    u32x4 w; w.x = cvt_pk_bf16(v0[0], v0[1]); w.y = cvt_pk_bf16(v0[2], v0[3]); w.z = cvt_pk_bf16(v1[0], v1[1]); w.w = cvt_pk_bf16(v1[2], v1[3]);
                    *(u32x4*)(rowp + bj * HALF) = w; } }
        zero_acc(acc);
    } };
struct EpiProj { static constexpr bool PERM = true; bf16_t* P; bf16_t* KMB; bf16_t* VMB; bf16_t* KSW; bf16_t* VSW; float* kmean;
    __device__ __forceinline__ void operator()(Acc& acc, const Unit& u, int wr, int wc, int fr, int fq) const {
        const int pn = u.pn; const int row0 = u.pm * BM + wr * 64 + fr;
        if (pn < 2 || pn == 6 || pn == 7 || pn >= 9) {
            const int pcol = (pn < 2) ? pn * BM : (pn < 8) ? C_QSW + (pn - 6) * BM : C_QME + (pn - 9) * BM;
            const float sc = (pn < 8) ? C2_64 : (pn < 11) ? C2_128 : 1.0f; const bool sg = pn >= 11;
#pragma unroll
            for (int ai = 0; ai < 2; ++ai)
#pragma unroll
                for (int m = 0; m < 4; ++m) { bf16_t* rowp = P + (size_t)(row0 + ai * HALF + m * 16) * PJW + pcol + wc * 32 + 8 * fq;
#pragma unroll
                    for (int bj = 0; bj < 2; ++bj) { f32x4 v0 = acc[ai][bj][m][0] * sc, v1 = acc[ai][bj][m][1] * sc;
                        if (sg) {
#pragma unroll
                            for (int j = 0; j < 4; ++j) { v0[j] = fast_sigmoid(v0[j]); v1[j] = fast_sigmoid(v1[j]); } }
                        u32x4 w; w.x = cvt_pk_bf16(v0[0], v0[1]); w.y = cvt_pk_bf16(v0[2], v0[3]); w.z = cvt_pk_bf16(v1[0], v1[1]); w.w = cvt_pk_bf16(v1[2], v1[3]);
                        *(u32x4*)(rowp + bj * HALF) = w; } }
        } else {
            const int b = u.pm >> 5, s0 = (u.pm & 31) * BM + wr * 64 + fr;
#pragma unroll
            for (int bj = 0; bj < 2; ++bj) {
                const int cin = bj * HALF + wc * 32 + 8 * fq;
                bf16_t* base; bool isk; int hd;
                if (pn == 8) { isk = bj == 0; hd = cin & 127; base = (isk ? KSW : VSW) + (size_t)(b * 2 + (hd >> 6)) * SEQ * 64; }
                else { isk = pn < 4; hd = (pn & 1) * BM + cin; base = (isk ? KMB : VMB) + (size_t)(b * 8 + (hd >> 6)) * SEQ * 64; }
                const int d0 = hd & 63;
#pragma unroll
                for (int ai = 0; ai < 2; ++ai)
#pragma unroll
                    for (int m = 0; m < 4; ++m) { const int s = s0 + ai * HALF + m * 16, tile = s >> 6, r = s & 63;
                        bf16_t* dst = base + (size_t)tile * 4096 + (isk ? ((d0 >> 3) * 64 + r) * 8 : ((d0 >> 5) * 64 + r) * 32 + (d0 & 31));
                        const f32x4 v0 = acc[ai][bj][m][0], v1 = acc[ai][bj][m][1];
                        u32x4 w; w.x = cvt_pk_bf16(v0[0], v0[1]); w.y = cvt_pk_bf16(v0[2], v0[3]); w.z = cvt_pk_bf16(v1[0], v1[1]); w.w = cvt_pk_bf16(v1[2], v1[3]);
                        *(u32x4*)dst = w; } }
        }
        if (pn == 2 || pn == 3) {
            float* kb = kmean + ((size_t)(u.pm >> 5) * 8 * NBLK + (u.pm & 31)) * 64;
#pragma unroll
            for (int bj = 0; bj < 2; ++bj)
#pragma unroll
                for (int n = 0; n < 2; ++n)
#pragma unroll
                    for (int j = 0; j < 4; ++j) { float s = 0.f;
#pragma unroll
                        for (int ai = 0; ai < 2; ++ai)
#pragma unroll
                            for (int m = 0; m < 4; ++m) s += acc[ai][bj][m][n][j];
                        s += __shfl_xor(s, 1); s += __shfl_xor(s, 2); s += __shfl_xor(s, 4); s += __shfl_xor(s, 8);
                        const int hd = (pn - 2) * 256 + bj * 128 + wc * 32 + 8 * fq + 4 * n + j;
                        if (fr == 0) atomicAdd(kb + (size_t)(hd >> 6) * NBLK * 64 + (hd & 63), s * (1.0f / MBLK)); } }
        zero_acc(acc);
    } };
struct EpiMemKV { static constexpr bool PERM = true; bf16_t* MK; bf16_t* MV;
    __device__ __forceinline__ void operator()(Acc& acc, const Unit& u, int wr, int wc, int fr, int fq) const {
        const int b = u.pm, m0 = wr * 64 + fr;
#pragma unroll
        for (int bj = 0; bj < 2; ++bj) { const int col = u.pn * BM + bj * HALF + wc * 32 + 8 * fq; const bool isk = col < 512; const int hd = col & 511, mh = hd >> 7, d0 = hd & 127;
            bf16_t* base = (isk ? MK : MV) + (size_t)(b * 4 + mh) * MEMLEN * 128;
#pragma unroll
            for (int ai = 0; ai < 2; ++ai)
#pragma unroll
                for (int m = 0; m < 4; ++m) { const int s = m0 + ai * HALF + m * 16, tile = s >> 6, r = s & 63;
                    bf16_t* dst = base + (size_t)tile * 8192 + (isk ? ((d0 >> 3) * 64 + r) * 8 : ((d0 >> 5) * 64 + r) * 32 + (d0 & 31));
                    const f32x4 v0 = acc[ai][bj][m][0], v1 = acc[ai][bj][m][1];
                    u32x4 w; w.x = cvt_pk_bf16(v0[0], v0[1]); w.y = cvt_pk_bf16(v0[2], v0[3]); w.z = cvt_pk_bf16(v1[0], v1[1]); w.w = cvt_pk_bf16(v1[2], v1[3]);
                    *(u32x4*)dst = w; } }
        zero_acc(acc);
    } };
struct EpiBranch { static constexpr bool PERM = true; const bf16_t* P; bf16_t* MG;
    __device__ __forceinline__ void operator()(Acc& acc, const Unit& u, int wr, int wc, int fr, int fq) const {
        const int row0 = u.pm * BM + wr * 64 + fr, col0 = u.pn * BM + wc * 32 + 8 * fq; const int sub = u.sub;
#pragma unroll
        for (int ai = 0; ai < 2; ++ai) {
            u32x4 ga[4][2], gb[4][2];
#pragma unroll
            for (int m = 0; m < 4; ++m)
#pragma unroll
                for (int bj = 0; bj < 2; ++bj) { const bf16_t* gp = P + (size_t)(row0 + ai * HALF + m * 16) * PJW + C_GMB + 1024 * sub + col0 + bj * HALF;
                    ga[m][bj] = *(const u32x4*)gp; gb[m][bj] = (sub < 2) ? *(const u32x4*)(gp + 1024) : (u32x4){0x3f803f80u, 0x3f803f80u, 0x3f803f80u, 0x3f803f80u}; }
#pragma unroll
            for (int m = 0; m < 4; ++m) { const size_t row = (size_t)(row0 + ai * HALF + m * 16);
#pragma unroll
                for (int bj = 0; bj < 2; ++bj) { float f[8];
#pragma unroll
                    for (int j = 0; j < 4; ++j) { f[2 * j] = __builtin_bit_cast(float, ga[m][bj][j] << 16); f[2 * j + 1] = __builtin_bit_cast(float, ga[m][bj][j] & 0xffff0000u); }
                    if (sub < 2) {
#pragma unroll
                        for (int j = 0; j < 4; ++j) { f[2 * j] *= fast_rcp(fmaxf(__builtin_bit_cast(float, gb[m][bj][j] << 16), 1e-20f)); f[2 * j + 1] *= fast_rcp(fmaxf(__builtin_bit_cast(float, gb[m][bj][j] & 0xffff0000u), 1e-20f)); } }
                    f32x4 v0 = acc[ai][bj][m][0], v1 = acc[ai][bj][m][1];
                    v0[0] *= f[0]; v0[1] *= f[1]; v0[2] *= f[2]; v0[3] *= f[3]; v1[0] *= f[4]; v1[1] *= f[5]; v1[2] *= f[6]; v1[3] *= f[7];
                    if (sub == 2) { u32x4 w; w.x = cvt_pk_bf16(v0[0], v0[1]); w.y = cvt_pk_bf16(v0[2], v0[3]); w.z = cvt_pk_bf16(v1[0], v1[1]); w.w = cvt_pk_bf16(v1[2], v1[3]);
                        *(u32x4*)(MG + row * D + col0 + bj * HALF) = w; v0 = (f32x4){0.f, 0.f, 0.f, 0.f}; v1 = v0; }
                    acc[ai][bj][m][0] = v0; acc[ai][bj][m][1] = v1; } } }
    } };
__device__ __forceinline__ float dpp_ror(float v, int n) { return n == 1 ? __builtin_bit_cast(float, __builtin_amdgcn_update_dpp(0, __builtin_bit_cast(int, v), 0x121, 0xf, 0xf, false))
                                                                         : __builtin_bit_cast(float, __builtin_amdgcn_update_dpp(0, __builtin_bit_cast(int, v), 0x122, 0xf, 0xf, false)); }
__device__ __forceinline__ float dpp_shr(float old, float v, int n) { return n == 1 ? __builtin_bit_cast(float, __builtin_amdgcn_update_dpp(__builtin_bit_cast(int, old), __builtin_bit_cast(int, v), 0x111, 0xf, 0xf, false))
                                                                                   : __builtin_bit_cast(float, __builtin_amdgcn_update_dpp(__builtin_bit_cast(int, old), __builtin_bit_cast(int, v), 0x112, 0xf, 0xf, false)); }
struct EpiUp { static constexpr bool PERM = true; bf16_t* ACT; bf16_t* EDGE; const float* convp;
    __device__ __forceinline__ void operator()(Acc& acc, const Unit& u, int wr, int wc, int fr, int fq) const {
        const int row0 = u.pm * BM + wr * 64 + fr; const int tcol = u.pn * BM + wc * 32 + 8 * fq;
        const int ch0 = u.pn * 128 + wc * 32 + 8 * fq;
#pragma unroll
        for (int n = 0; n < 2; ++n) {
            const float* cp = convp + tcol + 4 * n;
            const f32x4 g0 = *(const f32x4*)(cp), g1 = *(const f32x4*)(cp + UPW), g2 = *(const f32x4*)(cp + 2 * UPW), gb = *(const f32x4*)(cp + 3 * UPW);
            const f32x4 w0 = *(const f32x4*)(cp + HALF), w1 = *(const f32x4*)(cp + HALF + UPW), w2 = *(const f32x4*)(cp + HALF + 2 * UPW), wb = *(const f32x4*)(cp + HALF + 3 * UPW);
#pragma unroll
            for (int ai = 0; ai < 2; ++ai) {
                const int g64 = (u.pm * BM + ai * HALF + wr * 64) >> 6;
#pragma unroll
                for (int m = 0; m < 4; ++m) {
                    const f32x4 cg = acc[ai][0][m][n], cv = acc[ai][1][m][n];
                    f32x4 pg = cg, pv = cv; if (m > 0) { pg = acc[ai][0][m - 1][n]; pv = acc[ai][1][m - 1][n]; }
                    f32x4 og, ov;
#pragma unroll
                    for (int j = 0; j < 4; ++j) {
                        const float a1 = dpp_shr(dpp_ror(pg[j], 1), cg[j], 1), a2 = dpp_shr(dpp_ror(pg[j], 2), cg[j], 2);
                        const float b1 = dpp_shr(dpp_ror(pv[j], 1), cv[j], 1), b2 = dpp_shr(dpp_ror(pv[j], 2), cv[j], 2);
                        const float ug = gb[j] + g2[j] * cg[j] + g1[j] * a1 + g0[j] * a2, uv = wb[j] + w2[j] * cv[j] + w1[j] * b1 + w0[j] * b2;
                        og[j] = ug; ov[j] = uv; }
                    u32x2 w; w.x = cvt_pk_bf16(fast_gelu(og[0]) * ov[0], fast_gelu(og[1]) * ov[1]); w.y = cvt_pk_bf16(fast_gelu(og[2]) * ov[2], fast_gelu(og[3]) * ov[3]);
                    if (m > 0 || fr >= 2) *(u32x2*)(ACT + (size_t)(row0 + ai * HALF + m * 16) * FF + ch0 + 4 * n) = w;
                    if ((m == 0 && fr < 2) || (m == 3 && fr >= 14)) {
                        const int e = (m == 0) ? fr : fr - 12; bf16_t* ep = EDGE + ((size_t)g64 * 4 + e) * UPW + tcol + 4 * n;
                        u32x2 r0, r1; r0.x = cvt_pk_bf16(cg[0], cg[1]); r0.y = cvt_pk_bf16(cg[2], cg[3]); r1.x = cvt_pk_bf16(cv[0], cv[1]); r1.y = cvt_pk_bf16(cv[2], cv[3]);
                        *(u32x2*)ep = r0; *(u32x2*)(ep + HALF) = r1; }
                } } }
        zero_acc(acc);
    } };
}
namespace att {
typedef LAS const char* lds_cptr;
typedef short v4i16_t __attribute__((ext_vector_type(4)));
constexpr int SET_BYTES = 65536;
constexpr int L_TAB = 132096, L_PRE = 140288, L_LC = 142352;
#define ATT_WAIT_BAR() asm volatile("s_waitcnt vmcnt(0) lgkmcnt(0)\n\ts_barrier" ::: "memory")
#define ATT_MFMA(a, b, c) __builtin_amdgcn_mfma_f32_32x32x16_bf16(a, b, c, 0, 0, 0)
__device__ __forceinline__ void glds16(const void* g, unsigned lds_base) {
    unsigned sv; asm volatile("s_mov_b32 %0, m0\n\ts_mov_b32 m0, %2\n\ts_nop 0\n\tglobal_load_lds_dwordx4 %1, off\n\ts_mov_b32 m0, %0" : "=&s"(sv) : "v"(g), "s"(lds_base) : "memory"); }
__device__ __forceinline__ s16x4 vtr(lds_cptr p) { return __builtin_bit_cast(s16x4, __builtin_amdgcn_ds_read_tr16_b64_v4i16((LAS v4i16_t*)p)); }

template <int DH> struct State { f32x16 o[DH / 32]; float m, l; };
template <int DH> __device__ __forceinline__ void init_state(State<DH>& s, float m0, float l0) {
#pragma unroll
    for (int i = 0; i < DH / 32; ++i) s.o[i] = f32x16{};
    s.m = m0; s.l = l0; }

template <int DH> __device__ __forceinline__ void stage_tile(unsigned lds0, int kbuf, int vbuf, const bf16_t* kimg, const bf16_t* vimg, int wid, int lane) {
#pragma unroll
    for (int i = 0; i < DH / 64; ++i) { const int p = wid + 8 * i;
        glds16(kimg + p * 512 + lane * 8, (unsigned)__builtin_amdgcn_readfirstlane(lds0 + kbuf + p * 1024));
        glds16(vimg + p * 512 + lane * 8, (unsigned)__builtin_amdgcn_readfirstlane(lds0 + vbuf + p * 1024)); }
}
template <int DH, class BiasF> __device__ __forceinline__ void tile_step(State<DH>& st, lds_cptr kb, lds_cptr vb, const bf16x8 (&qr)[DH / 16], const BiasF& bias, int lane) {
    const int r32 = lane & 31, hi = lane >> 5;
    f32x16 p0 = f32x16{}, p1 = f32x16{};
    const lds_cptr kp = kb + hi * 1024 + r32 * 16;
#pragma unroll
    for (int d0 = 0; d0 < DH / 16; ++d0) { const bf16x8 k0 = *(const LAS bf16x8*)(kp + d0 * 2048), k1 = *(const LAS bf16x8*)(kp + d0 * 2048 + 512);
        p0 = ATT_MFMA(k0, qr[d0], p0); p1 = ATT_MFMA(k1, qr[d0], p1); }
    bias(p0, p1);
    float rm = fmaxf(p0[0], p1[0]);
#pragma unroll
    for (int r = 1; r < 16; ++r) rm = fmaxf(rm, fmaxf(p0[r], p1[r]));
    rm = fmaxf(rm, __shfl_xor(rm, 32));
    const float mn = fmaxf(st.m, rm), alpha = fast_exp2(st.m - mn); st.m = mn;
    float ls = 0.f;
#pragma unroll
    for (int r = 0; r < 16; ++r) { p0[r] = fast_exp2(p0[r] - mn); p1[r] = fast_exp2(p1[r] - mn); ls += p0[r] + p1[r]; }
    st.l = st.l * alpha + ls;
    if (!__all(alpha == 1.0f)) {
#pragma unroll
        for (int i = 0; i < DH / 32; ++i)
#pragma unroll
            for (int r = 0; r < 16; ++r) st.o[i][r] *= alpha; }
    u32x4 pw[4];
#pragma unroll
    for (int j = 0; j < 4; ++j) { pw[0][j] = cvt_pk_bf16(p0[2 * j], p0[2 * j + 1]); pw[1][j] = cvt_pk_bf16(p0[8 + 2 * j], p0[9 + 2 * j]); pw[2][j] = cvt_pk_bf16(p1[2 * j], p1[2 * j + 1]); pw[3][j] = cvt_pk_bf16(p1[8 + 2 * j], p1[9 + 2 * j]); }
    const lds_cptr vp = vb + ((lane >> 4) & 1) * 32 + (lane & 3) * 8 + (4 * hi + ((lane & 15) >> 2)) * 64;
#pragma unroll
    for (int ks = 0; ks < 4; ++ks)
#pragma unroll
        for (int db = 0; db < DH / 32; ++db) { const s16x4 lo = vtr(vp + db * 4096 + ks * 1024), up = vtr(vp + db * 4096 + ks * 1024 + 512);
            const bf16x8 vf = (bf16x8){lo[0], lo[1], lo[2], lo[3], up[0], up[1], up[2], up[3]};
            st.o[db] = ATT_MFMA(vf, __builtin_bit_cast(bf16x8, pw[ks]), st.o[db]); }
}
template <int DH> __device__ __forceinline__ void stage_block(unsigned lds0, int setoff, const bf16_t* kimg0, const bf16_t* vimg0, unsigned tmask, int wid, int lane) {
    constexpr int KT = DH * 128;
#pragma unroll
    for (int t = 0; t < 4; ++t) if ((tmask >> t) & 1u) stage_tile<DH>(lds0, setoff + t * KT, setoff + 4 * KT + t * KT, kimg0 + (ptrdiff_t)t * 64 * DH, vimg0 + (ptrdiff_t)t * 64 * DH, wid, lane);
}
template <int DH, class BiasMk> __device__ __forceinline__ void compute_block(State<DH>& st, lds_cptr set, const bf16x8 (&qr)[DH / 16], unsigned need, const BiasMk& mk, int lane) {
    constexpr int KT = DH * 128;
#pragma unroll 1
    for (int t = 0; t < 4; ++t) if ((need >> t) & 1u) tile_step<DH>(st, set + t * KT, set + 4 * KT + t * KT, qr, mk(t), lane);
}
template <int DH> __device__ __forceinline__ void load_q(bf16x8 (&qr)[DH / 16], const bf16_t* qrow, int hi) {
#pragma unroll
    for (int d0 = 0; d0 < DH / 16; ++d0) qr[d0] = *(const bf16x8*)(qrow + d0 * 16 + hi * 8);
}
struct NoBias { __device__ __forceinline__ void operator()(f32x16&, f32x16&) const {} };
struct MkNoBias { __device__ __forceinline__ NoBias operator()(int) const { return NoBias{}; } };
template <bool WIN> struct MkCInit { const LAS float* ext; int dq, hi;
    __device__ __forceinline__ void operator()(int t, f32x16& c0, f32x16& c1) const {
        const int base = dq - 64 * t - 4 * hi;
        if (!WIN) { if (__all(base - 59 >= 128)) { c0 = f32x16{}; c1 = f32x16{}; return; } }
        int bc = base < -1 ? -1 : (base > 187 ? 187 : base); asm volatile("" : "+v"(bc));
        const LAS float* p = ext + bc;
#pragma unroll
        for (int r = 0; r < 16; ++r) { const int cr = (r & 3) + 8 * (r >> 2); c0[r] = p[-cr]; c1[r] = p[-cr - 32]; }
    } };
struct MkCZero { __device__ __forceinline__ void operator()(int, f32x16& c0, f32x16& c1) const { c0 = f32x16{}; c1 = f32x16{}; } };
#define ATT_SBAR() __builtin_amdgcn_sched_barrier(0)
#define ATT_PIN(x) asm volatile("" : "+v"(x))
__device__ __forceinline__ float rowmax32(const f32x16& p0, const f32x16& p1) {
    float a = fmaxf(fmaxf(p0[0], p0[1]), p1[0]), b = fmaxf(fmaxf(p0[2], p0[3]), p1[1]); a = fmaxf(fmaxf(a, p1[2]), p1[3]);
#pragma unroll
    for (int r = 4; r < 16; r += 4) { a = fmaxf(fmaxf(a, p0[r]), p0[r + 1]); b = fmaxf(fmaxf(b, p0[r + 2]), p0[r + 3]); a = fmaxf(fmaxf(a, p1[r]), p1[r + 1]); b = fmaxf(fmaxf(b, p1[r + 2]), p1[r + 3]); }
    const float m = fmaxf(a, b); auto rr = __builtin_amdgcn_permlane32_swap(__float_as_uint(m), __float_as_uint(m), false, false);
    return fmaxf(__uint_as_float(rr[0]), __uint_as_float(rr[1])); }
template <bool START_REF, class BiasMk> __device__ __forceinline__ void block64(f32x16 (&o)[2], float& mhat, float& l_reg, lds_cptr set, const bf16x8 (&qr)[4], int t0, int t1, const BiasMk& mk, int lane) {
    constexpr int KT = 8192; constexpr float THR = 8.0f;
    const int r32 = lane & 31, hi = lane >> 5;
    const lds_cptr kbase = set + hi * 1024 + r32 * 16;
    const lds_cptr vbase = set + 4 * KT + ((lane >> 4) & 1) * 32 + (lane & 3) * 8 + (4 * hi + ((lane & 15) >> 2)) * 64;
    bf16x8 kf[8]; s16x4 vlo[4], vhi[4]; u32x4 pw0, pw1, pw2, pw3; f32x16 pA0, pA1, pB0, pB1; bool resc = false; float fsave = 1.0f;
#define KLD2(kp_, j_) do { kf[2 * (j_)] = *(const LAS bf16x8*)((kp_) + (j_) * 2048); kf[2 * (j_) + 1] = *(const LAS bf16x8*)((kp_) + (j_) * 2048 + 512); } while (0)
#define PKW(P, i) cvt_pk_bf16(P[i], P[(i) + 1])
#define PAF(k) __builtin_bit_cast(bf16x8, pw##k)
#define VFR(i) (bf16x8){vlo[i][0], vlo[i][1], vlo[i][2], vlo[i][3], vhi[i][0], vhi[i][1], vhi[i][2], vhi[i][3]}
#define VRDQ(slot, q) do { vlo[slot] = vtr(vp_ + (((q) & 1) * 4096 + ((q) >> 1) * 1024)); vhi[slot] = vtr(vp_ + (((q) & 1) * 4096 + ((q) >> 1) * 1024 + 512)); } while (0)
#define KRD(G, j_) do { if (G) { KLD2(kn_, j_); ATT_SBAR(); } } while (0)
#define GAPA(MF, a0, a1, a2, a3, W0, W1, PW) do { MF; sacc += a0; sacc += a1; sacc += a2; sacc += a3; W0; W1; ATT_PIN(PW); ATT_PIN(sacc); ATT_SBAR(); } while (0)
#define GAPB(MF, X, i) do { MF; X[i] = fast_exp2(X[i] - mhat); X[(i) + 1] = fast_exp2(X[(i) + 1] - mhat); X[(i) + 2] = fast_exp2(X[(i) + 2] - mhat); X[(i) + 3] = fast_exp2(X[(i) + 3] - mhat); ATT_PIN(X); ATT_SBAR(); } while (0)
#define DECIDE(C0, C1) do { const float rm_ = rowmax32(C0, C1) - mhat; resc = false; \
        if (__builtin_expect(__any(rm_ > THR), 0)) { const float dl_ = fmaxf(rm_, 0.f); mhat += dl_; \
            fsave = fast_exp2(-dl_); l_reg *= fsave; resc = true; } } while (0)
#define RESC() do { if (resc) { _Pragma("unroll") for (int d_ = 0; d_ < 2; ++d_) _Pragma("unroll") for (int r = 0; r < 16; ++r) o[d_][r] *= fsave; } } while (0)
    { const lds_cptr kp_ = kbase + t0 * KT; KLD2(kp_, 0); KLD2(kp_, 1); KLD2(kp_, 2); KLD2(kp_, 3); }
    mk(t0, pA0, pA1);
    pA0 = ATT_MFMA(kf[0], qr[0], pA0); pA1 = ATT_MFMA(kf[1], qr[0], pA1); pA0 = ATT_MFMA(kf[2], qr[1], pA0); pA1 = ATT_MFMA(kf[3], qr[1], pA1);
    pA0 = ATT_MFMA(kf[4], qr[2], pA0); pA1 = ATT_MFMA(kf[5], qr[2], pA1); pA0 = ATT_MFMA(kf[6], qr[3], pA0); pA1 = ATT_MFMA(kf[7], qr[3], pA1);
    if (START_REF) mhat = rowmax32(pA0, pA1);
    else { DECIDE(pA0, pA1); }
#pragma unroll
    for (int r = 0; r < 16; ++r) { pA0[r] = fast_exp2(pA0[r] - mhat); pA1[r] = fast_exp2(pA1[r] - mhat); }
    if (t0 < t1) { const lds_cptr kp_ = kbase + (t0 + 1) * KT; KLD2(kp_, 0); KLD2(kp_, 1); KLD2(kp_, 2); KLD2(kp_, 3); }
#define STEP(C0, C1, P0, P1, t, GL) do { ATT_SBAR(); \
    const lds_cptr vp_ = vbase + ((t) - 1) * KT; const lds_cptr kn_ = kbase + ((t) + 1) * KT; \
    mk(t, C0, C1); ATT_SBAR(); \
    float sacc = P0[0] + P0[1]; \
    GAPA(C0 = ATT_MFMA(kf[0], qr[0], C0),   P0[2], P0[3], P0[4], P0[5],     pw0[0] = PKW(P0, 0),  pw0[1] = PKW(P0, 2),  pw0); \
    GAPA(C1 = ATT_MFMA(kf[1], qr[0], C1),   P0[6], P0[7], P0[8], P0[9],     pw0[2] = PKW(P0, 4),  pw0[3] = PKW(P0, 6),  pw0); \
    GAPA(C0 = ATT_MFMA(kf[2], qr[1], C0),   P0[10], P0[11], P0[12], P0[13], pw1[0] = PKW(P0, 8),  pw1[1] = PKW(P0, 10), pw1); \
    GAPA(C1 = ATT_MFMA(kf[3], qr[1], C1),   P0[14], P0[15], P1[0], P1[1],   pw1[2] = PKW(P0, 12), pw1[3] = PKW(P0, 14), pw1); \
    GAPA(C0 = ATT_MFMA(kf[4], qr[2], C0),   P1[2], P1[3], P1[4], P1[5],     pw2[0] = PKW(P1, 0),  pw2[1] = PKW(P1, 2),  pw2); \
    GAPA(C1 = ATT_MFMA(kf[5], qr[2], C1),   P1[6], P1[7], P1[8], P1[9],     pw2[2] = PKW(P1, 4),  pw2[3] = PKW(P1, 6),  pw2); \
    VRDQ(0, 0); ATT_SBAR(); GAPA(C0 = ATT_MFMA(kf[6], qr[3], C0),   P1[10], P1[11], P1[12], P1[13], pw3[0] = PKW(P1, 8),  pw3[1] = PKW(P1, 10), pw3); \
    VRDQ(1, 1); ATT_SBAR(); GAPA(C1 = ATT_MFMA(kf[7], qr[3], C1),   P1[14], P1[15], 0.f, 0.f,       pw3[2] = PKW(P1, 12), pw3[3] = PKW(P1, 14), pw3); \
    l_reg += sacc; \
    DECIDE(C0, C1); ATT_SBAR(); \
    VRDQ(2, 2); ATT_SBAR(); GAPB(o[0] = ATT_MFMA(VFR(0), PAF(0), o[0]), C0, 0); \
    VRDQ(3, 3); ATT_SBAR(); GAPB(o[1] = ATT_MFMA(VFR(1), PAF(0), o[1]), C0, 4); \
    VRDQ(0, 4); ATT_SBAR(); KRD(GL, 0); GAPB(o[0] = ATT_MFMA(VFR(2), PAF(1), o[0]), C0, 8); \
    VRDQ(1, 5); ATT_SBAR(); KRD(GL, 1); GAPB(o[1] = ATT_MFMA(VFR(3), PAF(1), o[1]), C0, 12); \
    VRDQ(2, 6); ATT_SBAR(); KRD(GL, 2); GAPB(o[0] = ATT_MFMA(VFR(0), PAF(2), o[0]), C1, 0); \
    VRDQ(3, 7); ATT_SBAR(); KRD(GL, 3); GAPB(o[1] = ATT_MFMA(VFR(1), PAF(2), o[1]), C1, 4); \
    GAPB(o[0] = ATT_MFMA(VFR(2), PAF(3), o[0]), C1, 8); \
    GAPB(o[1] = ATT_MFMA(VFR(3), PAF(3), o[1]), C1, 12); \
    RESC(); } while (0)
#define DRAIN(P0, P1, t) do { float sacc = P0[0] + P0[1]; \
    _Pragma("unroll") for (int r = 2; r < 16; ++r) sacc += P0[r]; \
    _Pragma("unroll") for (int r = 0; r < 16; ++r) sacc += P1[r]; \
    l_reg += sacc; \
    pw0 = (u32x4){PKW(P0, 0), PKW(P0, 2), PKW(P0, 4), PKW(P0, 6)}; pw1 = (u32x4){PKW(P0, 8), PKW(P0, 10), PKW(P0, 12), PKW(P0, 14)}; \
    pw2 = (u32x4){PKW(P1, 0), PKW(P1, 2), PKW(P1, 4), PKW(P1, 6)}; pw3 = (u32x4){PKW(P1, 8), PKW(P1, 10), PKW(P1, 12), PKW(P1, 14)}; \
    const lds_cptr vp_ = vbase + (t) * KT; VRDQ(0, 0); VRDQ(1, 1); VRDQ(2, 2); VRDQ(3, 3); \
    o[0] = ATT_MFMA(VFR(0), PAF(0), o[0]); o[1] = ATT_MFMA(VFR(1), PAF(0), o[1]); o[0] = ATT_MFMA(VFR(2), PAF(1), o[0]); o[1] = ATT_MFMA(VFR(3), PAF(1), o[1]); ATT_SBAR(); \
    VRDQ(0, 4); VRDQ(1, 5); VRDQ(2, 6); VRDQ(3, 7); \
    o[0] = ATT_MFMA(VFR(0), PAF(2), o[0]); o[1] = ATT_MFMA(VFR(1), PAF(2), o[1]); o[0] = ATT_MFMA(VFR(2), PAF(3), o[0]); o[1] = ATT_MFMA(VFR(3), PAF(3), o[1]); } while (0)
    const int nt = t1 - t0;
    if (nt >= 1) { const int t = t0 + 1; const bool gl = nt >= 2; STEP(pB0, pB1, pA0, pA1, t, gl); }
    if (nt >= 2) { const int t = t0 + 2; const bool gl = nt >= 3; STEP(pA0, pA1, pB0, pB1, t, gl); }
    if (nt >= 3) { const int t = t0 + 3; STEP(pB0, pB1, pA0, pA1, t, false); }
    if (nt & 1) { DRAIN(pB0, pB1, t1); } else { DRAIN(pA0, pA1, t1); }
#undef KLD2
#undef PKW
#undef PAF
#undef VFR
#undef VRDQ
#undef KRD
#undef GAPA
#undef GAPB
#undef DECIDE
#undef RESC
#undef STEP
#undef DRAIN
}
template <int DH> __device__ __forceinline__ void store_rows(const State<DH>& st, float ltot, bf16_t* orow, bool valid, int hi) {
    const float inv = fast_rcp(ltot);
    if (valid) {
#pragma unroll
        for (int db = 0; db < DH / 32; ++db)
#pragma unroll
            for (int g = 0; g < 4; ++g) { u32x2 w; w.x = cvt_pk_bf16(st.o[db][4 * g] * inv, st.o[db][4 * g + 1] * inv); w.y = cvt_pk_bf16(st.o[db][4 * g + 2] * inv, st.o[db][4 * g + 3] * inv);
                *(u32x2*)(orow + 32 * db + 8 * g + 4 * hi) = w; } }
}
}
constexpr size_t WS_BARW = 0;
constexpr int CW_BAR = 4096;
constexpr size_t WS_LCNT = 256 * 1024;
constexpr size_t WS_CNT = 42 * MiB;
constexpr size_t WS_PO01 = 44 * MiB;
constexpr size_t WS_PO2 = 476 * MiB;
constexpr size_t DO_PL = 96 * MiB, DO_SEG = 100 * MiB;
constexpr int LIST_BH = 256 * 496;
constexpr int RING_BYTES = 131072, LDSCTL_OFF = RING_BYTES, MISC_OFF = LDSCTL_OFF + 320, LDS_BYTES = 147456;
constexpr int NWAVES = 8;
constexpr int NPHASE = 12;
#ifndef REP2
#define REP2 1
#endif
#ifndef REP3
#define REP3 1
#endif
#ifndef REP8
#define REP8 1
#endif
#ifndef REP1
#define REP1 1
#endif

#define XB_TMO      128
#define XB_XCNT(j)  (256  + 64 * (j))
#define XB_XSUB(j)  (1280 + 64 * (j))
#define XB_XGEN(j)  (2304 + 64 * (j))
#define XB_TOP      3328
#define XB_TOPGEN   3392
#define XCD_BAR_WORDS 3456
#define XB_SPIN_CAP (1u << 18)

__device__ __forceinline__ unsigned xb_ld(unsigned* p)              { return __hip_atomic_load(p, __ATOMIC_RELAXED, __HIP_MEMORY_SCOPE_AGENT); }
__device__ __forceinline__ unsigned xb_add(unsigned* p, unsigned v) { return __hip_atomic_fetch_add(p, v, __ATOMIC_RELAXED, __HIP_MEMORY_SCOPE_AGENT); }
__device__ __forceinline__ unsigned xb_xcc_id() { return (unsigned)__builtin_amdgcn_s_getreg((3 << 11) | 20) & 0xFu; }
#define XB_SPIN(cond, bar) do { unsigned _sp = 0; while (cond) { __builtin_amdgcn_s_sleep(1); \
    if ((++_sp & 255u) == 0u) { if (xb_ld(&(bar)[XB_TMO])) break; if (_sp > XB_SPIN_CAP) { atomicAdd(&(bar)[XB_TMO], 1u); break; } } } } while (0)

struct XcdBarrier {
    unsigned* bar; unsigned x;
    volatile LAS unsigned* st;
};

__device__ __forceinline__ XcdBarrier xcd_barrier_post(unsigned* bar, volatile LAS unsigned* st) {
    XcdBarrier b; b.bar = bar; b.x = xb_xcc_id(); b.st = st;
    if (threadIdx.x == 0) (void)xb_add(&bar[XB_XCNT(b.x)], 1u);
    return b;
}
__device__ __forceinline__ void xcd_barrier_complete(unsigned* bar, unsigned x, unsigned& nloc, unsigned& nx) {
    const unsigned G = gridDim.x * gridDim.y * gridDim.z;
    unsigned sum, cnt, mine, sp = 0u;
    for (;;) {
        sum = 0u; cnt = 0u; mine = 0u;
#pragma unroll
        for (unsigned j = 0; j < 16; ++j) { const unsigned c = xb_ld(&bar[XB_XCNT(j)]); sum += c; cnt += (c > 0u) ? 1u : 0u; mine = (j == x) ? c : mine; }
        if (sum == G) break;
        __builtin_amdgcn_s_sleep(1);
        if ((++sp & 255u) == 0u) { if (xb_ld(&bar[XB_TMO])) break; if (sp > XB_SPIN_CAP) { atomicAdd(&bar[XB_TMO], 1u); break; } }
    }
    nloc = mine > 0u ? mine : 1u; nx = cnt > 0u ? cnt : 1u;
}

__device__ __forceinline__ void xcd_barrier(const XcdBarrier& b) {
    asm volatile("s_waitcnt vmcnt(0)" ::: "memory");
    __syncthreads();
    if (threadIdx.x == 0) {
        unsigned* bar = b.bar;
        __builtin_amdgcn_s_waitcnt(0);
        unsigned nloc = b.st[0], nx = b.st[1];
        if (nloc == 0u) { xcd_barrier_complete(bar, b.x, nloc, nx); b.st[0] = nloc; b.st[1] = nx; }
        const unsigned old = xb_add(&bar[XB_XSUB(b.x)], 1u);
        const unsigned gen = old / nloc;
        if (old + 1u == (gen + 1u) * nloc) {
            __builtin_amdgcn_fence(__ATOMIC_RELEASE, "agent");
            asm volatile("s_waitcnt vmcnt(0)" ::: "memory");
            const unsigned og = xb_add(&bar[XB_TOP], 1u);
            const unsigned tg = og / nx;
            if (og + 1u == (tg + 1u) * nx) xb_add(&bar[XB_TOPGEN], 1u);
            else XB_SPIN(xb_ld(&bar[XB_TOPGEN]) == tg, bar);
            __builtin_amdgcn_fence(__ATOMIC_ACQUIRE, "agent");
            xb_add(&bar[XB_XGEN(b.x)], 1u);
            asm volatile("s_waitcnt vmcnt(0)" ::: "memory");
        } else {
            XB_SPIN(xb_ld(&bar[XB_XGEN(b.x)]) == gen, bar);
            __builtin_amdgcn_fence(__ATOMIC_ACQUIRE, "agent");
            asm volatile("s_waitcnt vmcnt(0)" ::: "memory");
        }
    }
    __syncthreads();
}


struct Args { const float* in[19]; float* out; unsigned char* ws; int ph_lo, ph_hi, li, pad; };

__device__ __forceinline__ unsigned long long pack4bf(float a, float b, float c, float d) { return (unsigned long long)(f2bf(a) | (f2bf(b) << 16)) | ((unsigned long long)(f2bf(c) | (f2bf(d) << 16)) << 32); }

template <int MAP> __device__ __forceinline__ void p0_transpose_item(const float* W, int K, int N, bf16_t* WT, int ld, int coff, LAS float* scr, int item, int lane) {
    const int nblk = N / 32, kb = item / nblk, nb = item % nblk, k0 = 64 * kb, n0 = 32 * nb;
#pragma unroll 8
    for (int i = 0; i < 32; ++i) { const int kk = 2 * i + (lane >> 5); scr[kk * 33 + (lane & 31)] = W[(size_t)(k0 + kk) * N + n0 + (lane & 31)]; }
    asm volatile("s_waitcnt lgkmcnt(0)" ::: "memory");
    const int c = lane & 7;
    int r0 = n0; if (MAP == 1) { const int isv = n0 >= FF, ch = isv ? n0 - FF : n0; r0 = 256 * (ch >> 7) + 128 * isv + (ch & 127); }
#pragma unroll
    for (int j = 0; j < 4; ++j) { const int n = (lane >> 3) + 8 * j; const LAS float* s = scr + (8 * c) * 33 + n;
        u32x4 o; o.x = f2bf(s[0 * 33]) | (f2bf(s[1 * 33]) << 16); o.y = f2bf(s[2 * 33]) | (f2bf(s[3 * 33]) << 16); o.z = f2bf(s[4 * 33]) | (f2bf(s[5 * 33]) << 16); o.w = f2bf(s[6 * 33]) | (f2bf(s[7 * 33]) << 16);
        *(u32x4*)(WT + (size_t)(r0 + n) * ld + coff + k0 + 8 * c) = o; }
    asm volatile("s_waitcnt lgkmcnt(0)" ::: "memory");
}
__device__ __forceinline__ void rms_row_bf16(const float* xrow, const float* g, bf16_t* orow, int lane) {
    const f32x4* xr = (const f32x4*)xrow + lane; f32x4 v[4]; float s = 0.f;
#pragma unroll
    for (int j = 0; j < 4; ++j) { v[j] = xr[64 * j]; s += v[j].x * v[j].x + v[j].y * v[j].y + v[j].z * v[j].z + v[j].w * v[j].w; }
    const float r = rsqrtf(wave_sum(s) * (1.0f / D) + RMS_EPS);
#pragma unroll
    for (int j = 0; j < 4; ++j) { const f32x4 gg = ((const f32x4*)g)[lane + 64 * j]; ((unsigned long long*)orow)[lane + 64 * j] = pack4bf(v[j].x * r * gg.x, v[j].y * r * gg.y, v[j].z * r * gg.z, v[j].w * r * gg.w); }
}

__global__ void __launch_bounds__(NWAVES * 64, 2) mega_fwd(Args args) {
    extern __shared__ __attribute__((aligned(16))) unsigned char lds_raw[];
    LAS unsigned char* lds = (LAS unsigned char*)lds_raw;
    volatile LAS unsigned* MISC = (volatile LAS unsigned*)(lds + MISC_OFF);
    const int tid = threadIdx.x, lane = tid & 63, wid = __builtin_amdgcn_readfirstlane(tid >> 6);
    const int G = gridDim.x, bx = blockIdx.x; const int vcu = (G % 8 == 0) ? (bx % 8) * (G / 8) + bx / 8 : bx;
    unsigned char* ws = args.ws; unsigned* ctl = (unsigned*)(ws + WS_CTL);
    const float* x = args.in[0]; const float* memx = args.in[1];
    const float *g_mix_pre = args.in[2], *g_mix_post = args.in[3], *g_ffn_pre = args.in[4], *g_ffn_post = args.in[5], *g_mem = args.in[6];
    const float *w_in = args.in[7], *rel_bias = args.in[8], *sinks = args.in[9], *w_mem_kv = args.in[10];
    const float *w_br_mb = args.in[11], *w_br_sw = args.in[12], *w_br_me = args.in[13], *w_out = args.in[14], *w_up = args.in[15];
    const float *conv_w = args.in[16], *conv_b = args.in[17], *w_down = args.in[18];
    float* out = args.out;
    bf16_t *Win_t = (bf16_t*)(ws + WS_WIN), *Wmkv_t = (bf16_t*)(ws + WS_WMEMKV), *Wbr_t = (bf16_t*)(ws + WS_WBR), *Wout_t = (bf16_t*)(ws + WS_WOUT), *Wup_t = (bf16_t*)(ws + WS_WUP), *Wdown_t = (bf16_t*)(ws + WS_WDOWN);
    bf16_t *HM = (bf16_t*)(ws + WS_HM), *MEMK = (bf16_t*)(ws + WS_MEMK), *MEMV = (bf16_t*)(ws + WS_MEMV), *H = (bf16_t*)(ws + WS_H), *PROJ = (bf16_t*)(ws + WS_PROJ), *KMB = (bf16_t*)(ws + WS_KMB), *VMB = (bf16_t*)(ws + WS_VMB), *KSW = (bf16_t*)(ws + WS_KSW), *VSW = (bf16_t*)(ws + WS_VSW), *OCAT = (bf16_t*)out, *MERGED = (bf16_t*)(ws + WS_H), *H2 = (bf16_t*)(ws + WS_H), *ACT = (bf16_t*)(ws + WS_ACT), *EDGE = (bf16_t*)(ws + WS_EDGE);
    float *tab = (float*)(ws + WS_TAB), *convp = tab + 2048, *kmean = (float*)(ws + WS_KMEAN), *X1 = out; bf16_t *Y1 = (bf16_t*)(ws + WS_Y1), *Y2 = (bf16_t*)(ws + WS_Y2);
    unsigned *LCNT = (unsigned*)(ws + WS_LCNT), *CNT = (unsigned*)(ws + WS_CNT);
    bf16_t *PO01 = (bf16_t*)(ws + WS_PO01), *PO2 = (bf16_t*)(ws + WS_PO2); float* PL = (float*)((unsigned char*)out + DO_PL); unsigned short* LIST = (unsigned short*)((unsigned char*)out + DO_SEG);

    for (int u = tid; u < (LDS_BYTES - LDSCTL_OFF) / 4; u += NWAVES * 64) ((LAS unsigned*)(lds + LDSCTL_OFF))[u] = 0u;
    __syncthreads();
    XcdBarrier bar = xcd_barrier_post((unsigned*)(ctl + CW_BAR) + args.li * XCD_BAR_WORDS, MISC + 8);
    const int lo = args.ph_lo, hi_ph = args.ph_hi;
#define IN(k) (lo <= (k) && (k) < hi_ph)
#ifdef PROBE_LO
#define STAMP(k) do { if (bx == 0 && tid == 0) { const unsigned long long t_ = __builtin_amdgcn_s_memrealtime(); MISC[16 + 2 * (k)] = (unsigned)t_; MISC[17 + 2 * (k)] = (unsigned)(t_ >> 32); } } while (0)
#else
#define STAMP(k) do {} while (0)
#endif
#define SEAM(k) do { if (IN(k) && IN((k) + 1)) xcd_barrier(bar); STAMP((k) + 1); } while (0)
    unsigned long long pr_acc = 0ull; (void)pr_acc;
#ifdef PROBE_REGION
    unsigned long long pr_t0 = 0ull;
#define PR_BEGIN(r) do { if ((r) == PROBE_REGION) pr_t0 = __builtin_amdgcn_s_memrealtime(); } while (0)
#define PR_END(r) do { if ((r) == PROBE_REGION) pr_acc += __builtin_amdgcn_s_memrealtime() - pr_t0; } while (0)
#else
#define PR_BEGIN(r) do {} while (0)
#define PR_END(r) do {} while (0)
#endif
    const int gw = vcu * NWAVES + wid, NGW = G * NWAVES;
    const int gt = vcu * (NWAVES * 64) + tid, NGT = G * NWAVES * 64;

    STAMP(0);
    if (IN(0)) {
        LAS float* scr = (LAS float*)(lds + wid * 16384);
        constexpr int I_IN = (D / 64) * (INW / 32), I_MKV = (D / 64) * (1024 / 32), I_BR = (512 / 64) * (D / 32), I_OUT = (D / 64) * (D / 32), I_UP = (D / 64) * (UPW / 32), I_DN = (FF / 64) * (D / 32);
        constexpr int NITEMS = I_IN + I_MKV + 3 * I_BR + I_OUT + I_UP + I_DN;
        for (int it = gw; it < NITEMS; it += NGW) { int r = it;
            if (r < I_IN) { p0_transpose_item<0>(w_in, D, INW, Win_t, D, 0, scr, r, lane); continue; } r -= I_IN;
            if (r < I_MKV) { p0_transpose_item<0>(w_mem_kv, D, 1024, Wmkv_t, D, 0, scr, r, lane); continue; } r -= I_MKV;
            if (r < I_BR) { p0_transpose_item<0>(w_br_mb, 512, D, Wbr_t, 1536, 0, scr, r, lane); continue; } r -= I_BR;
            if (r < I_BR) { p0_transpose_item<0>(w_br_sw, 512, D, Wbr_t, 1536, 512, scr, r, lane); continue; } r -= I_BR;
            if (r < I_BR) { p0_transpose_item<0>(w_br_me, 512, D, Wbr_t, 1536, 1024, scr, r, lane); continue; } r -= I_BR;
            if (r < I_OUT) { p0_transpose_item<0>(w_out, D, D, Wout_t, D, 0, scr, r, lane); continue; } r -= I_OUT;
            if (r < I_UP) { p0_transpose_item<1>(w_up, D, UPW, Wup_t, D, 0, scr, r, lane); continue; } r -= I_UP;
            p0_transpose_item<0>(w_down, FF, D, Wdown_t, FF, 0, scr, r, lane); }
        for (int m = gw; m < T; m += NGW) rms_row_bf16(x + (size_t)m * D, g_mix_pre, H + (size_t)m * D, lane);
        for (int m = gw; m < MROWS; m += NGW) rms_row_bf16(memx + (size_t)m * D, g_mem, HM + (size_t)m * D, lane);
        for (int i = gt; i < UPW; i += NGT) {
            if (i < 16 * 128) { const int h = i >> 7, d = i & 127; tab[i] = rel_bias[t5_bucket(d) * 16 + h] * LOG2E; }
            const int isv = i >= FF, ch = isv ? i - FF : i, col = 256 * (ch >> 7) + 128 * isv + (ch & 127);
            convp[0 * UPW + col] = conv_w[0 * UPW + i]; convp[1 * UPW + col] = conv_w[1 * UPW + i]; convp[2 * UPW + col] = conv_w[2 * UPW + i]; convp[3 * UPW + col] = conv_b[i]; }
    }
    SEAM(0);
    if (IN(1)) {
        { pg8::Gemm g{HM, Wmkv_t, D, D, D}; pg8::FewOrder S{4, 16, 128, bx}; pg8::EpiMemKV E{MEMK, MEMV}; pg8::gemm_phase(lds, g, S, E, pr_acc, 100); }
        { pg8::Gemm g{H, Win_t, D, D, D}; pg8::StaticOrder S; S.init(T, INW, G, bx); pg8::EpiProj E{PROJ, KMB, VMB, KSW, VSW, kmean}; pg8::gemm_phase(lds, g, S, E, pr_acc, 1); }
    }
    SEAM(1);
    if (IN(2)) {
        const unsigned lds0 = (unsigned)(uintptr_t)lds; const int r32 = lane & 31, hi = lane >> 5;
        for (int i = tid; i < 2048; i += NWAVES * 64) { const int h = i >> 8, d = (i & 255) - 64; ((LAS float*)(lds + att::L_TAB))[i] = (d >= 0 && d < 128) ? tab[(8 + h) * 128 + d] : -INFINITY; }
        __syncthreads();
        for (int uidx = vcu; uidx < 32 * NBLK; uidx += G) {
            const int bh = uidx >> 5, c = uidx & 31, b = bh >> 3, h = bh & 7;
            LAS float* km = (LAS float*)(lds);
            LAS float* candv = (LAS float*)(lds + 8192);
            LAS int* candi = (LAS int*)(lds + 8192 + 3072);
            LAS unsigned* selw = (LAS unsigned*)(lds + 8192 + 6144);
            for (int i = tid; i < c * 64; i += NWAVES * 64) km[i] = kmean[((size_t)bh * NBLK) * 64 + i];
            __syncthreads();
            const int q = tid & 255, half = tid >> 8; const int trow = b * SEQ + c * MBLK + q;
            float v0 = -INFINITY, v1 = -INFINITY, v2 = -INFINITY; int i0 = -1, i1 = -1, i2 = -1;
            { const bf16_t* qp = PROJ + (size_t)trow * PJW + C_QMB + h * 64; float qv[64];
#pragma unroll
              for (int j = 0; j < 8; ++j) { const u32x4 w = *(const u32x4*)(qp + 8 * j);
#pragma unroll
                  for (int e = 0; e < 4; ++e) { qv[8 * j + 2 * e] = __builtin_bit_cast(float, w[e] << 16); qv[8 * j + 2 * e + 1] = __builtin_bit_cast(float, w[e] & 0xffff0000u); } }
              const int n_lo = half * 16, n_hi = (n_lo + 16 < c) ? n_lo + 16 : c;
              for (int n = n_lo; n < n_hi; ++n) { const LAS float* kp = km + n * 64; float a = 0.f;
#pragma unroll
                  for (int d = 0; d < 64; ++d) a += qv[d] * kp[d];
                  if (a > v0) { v2 = v1; i2 = i1; v1 = v0; i1 = i0; v0 = a; i0 = n; } else if (a > v1) { v2 = v1; i2 = i1; v1 = a; i1 = n; } else if (a > v2) { v2 = a; i2 = n; } } }
            if (half == 1) { candv[q * 3] = v0; candv[q * 3 + 1] = v1; candv[q * 3 + 2] = v2; candi[q * 3] = i0; candi[q * 3 + 1] = i1; candi[q * 3 + 2] = i2; }
            __syncthreads();
            if (half == 0) {
#pragma unroll
                for (int k = 0; k < 3; ++k) { const float a = candv[q * 3 + k]; const int n = candi[q * 3 + k];
                    if (n >= 0) { if (a > v0) { v2 = v1; i2 = i1; v1 = v0; i1 = i0; v0 = a; i0 = n; } else if (a > v1) { v2 = v1; i2 = i1; v1 = a; i1 = n; } else if (a > v2) { v2 = a; i2 = n; } } }
                selw[q] = (unsigned)(i0 & 0xff) | ((unsigned)(i1 & 0xff) << 8) | ((unsigned)(i2 & 0xff) << 16);
            }
            __syncthreads();
            for (int n = wid; n < c; n += NWAVES) { int rk[4]; unsigned long long bal[4]; unsigned cnt = 0;
#pragma unroll
                for (int ch = 0; ch < 4; ++ch) { const unsigned s = selw[ch * 64 + lane]; rk[ch] = ((s & 0xff) == (unsigned)n) ? 0 : (((s >> 8) & 0xff) == (unsigned)n) ? 1 : (((s >> 16) & 0xff) == (unsigned)n) ? 2 : -1;
                    bal[ch] = __ballot(rk[ch] >= 0); cnt += (unsigned)__builtin_popcountll(bal[ch]); }
                unsigned base = 0; if (lane == 0 && cnt) base = atomicAdd(&LCNT[bh * NBLK + n], cnt);
                base = (unsigned)__builtin_amdgcn_readfirstlane((int)base);
                unsigned short* lp = LIST + (size_t)bh * LIST_BH + 256 * (31 * n - (n * (n - 1)) / 2);
#pragma unroll
                for (int ch = 0; ch < 4; ++ch) { const unsigned pos = base + (unsigned)__builtin_popcountll(bal[ch] & ((1ull << lane) - 1ull));
                    if (rk[ch] >= 0) lp[pos] = (unsigned short)((c << 10) | (rk[ch] << 8) | (ch * 64 + lane)); base += (unsigned)__builtin_popcountll(bal[ch]); } }
            __syncthreads();
        }
        {
            const int NU = BATCH * 2 * 64; int uidx = vcu, it = 0; bf16x8 qr[4];
            if (uidx < NU) { const int nb = uidx & 63, kvh = (uidx >> 6) & 1, b = uidx >> 7; const ptrdiff_t i0 = ((ptrdiff_t)(b * 2 + kvh) * (SEQ / 64) + (nb - 1) * 2) * 4096;
                att::stage_block<64>(lds0, 0, KSW + i0, VSW + i0, nb == 0 ? 0xcu : 0xfu, wid, lane); }
            for (; uidx < NU; uidx += G, ++it) {
                const int nb = uidx & 63, kvh = (uidx >> 6) & 1, b = uidx >> 7; const int wq = wid & 3;
                const int spos = nb * 128 + 32 * wq + r32; const size_t trow = (size_t)b * SEQ + spos;
                const int head0 = 4 * kvh + (wid >> 2);
                if (it == 0) att::load_q<64>(qr, PROJ + trow * PJW + C_QSW + head0 * 64, hi);
                ATT_WAIT_BAR();
                const int un = uidx + G;
                if (un < NU) { const int nb2 = un & 63, kvh2 = (un >> 6) & 1, b2 = un >> 7; const ptrdiff_t i0 = ((ptrdiff_t)(b2 * 2 + kvh2) * (SEQ / 64) + (nb2 - 1) * 2) * 4096;
                    att::stage_block<64>(lds0, ((it + 1) & 1) * att::SET_BYTES, KSW + i0, VSW + i0, nb2 == 0 ? 0xcu : 0xfu, wid, lane); }
                const att::lds_cptr set = (att::lds_cptr)lds + (it & 1) * att::SET_BYTES;
                const int t_first = (nb == 0) ? 2 : (wq < 2 ? 0 : 1), t_last = (wq < 2) ? 2 : 3;
#pragma unroll 1
                for (int hp = 0; hp < 2; ++hp) { const int head = head0 + 2 * hp;
                    att::State<64> st; att::init_state<64>(st, sinks[head] * LOG2E, hi == 0 ? 1.0f : 0.0f);
                    att::MkCInit<true> mk{(const LAS float*)(lds + att::L_TAB) + head * 256 + 64, 128 + 32 * wq + r32, hi};
                    att::block64<false>(st.o, st.m, st.l, set, qr, t_first, t_last, mk, lane);
                    const float ltot = st.l + __shfl_xor(st.l, 32);
                    att::store_rows<64>(st, ltot, OCAT + trow * 1536 + 512 + head * 64, true, hi);
                    if (hp == 0) att::load_q<64>(qr, PROJ + trow * PJW + C_QSW + (head0 + 2) * 64, hi);
                    else if (un < NU) { const int nb2 = un & 63, kvh2 = (un >> 6) & 1, b2 = un >> 7; att::load_q<64>(qr, PROJ + ((size_t)b2 * SEQ + nb2 * 128 + 32 * wq + r32) * PJW + C_QSW + (4 * kvh2 + (wid >> 2)) * 64, hi); } }
            }
            ATT_WAIT_BAR();
        }
        for (int uidx = vcu; uidx < BATCH * 4 * 16; uidx += G) {
            const int qp2 = uidx & 15, mh = (uidx >> 4) & 3, b = uidx >> 6;
            att::stage_block<128>(lds0, 0, MEMK + (size_t)(b * 4 + mh) * MEMLEN * 128, MEMV + (size_t)(b * 4 + mh) * MEMLEN * 128, 0xfu, wid, lane);
            bf16x8 qr[8];
#pragma unroll 1
            for (int ps = 0; ps < 2; ++ps) { const size_t trow = (size_t)b * SEQ + (qp2 * 2 + ps) * 256 + 32 * wid + r32;
                att::load_q<128>(qr, PROJ + trow * PJW + C_QME + mh * 128, hi);
                if (ps == 0) ATT_WAIT_BAR();
                att::State<128> st; att::init_state<128>(st, -3.0e38f, 0.f);
                att::compute_block<128>(st, (att::lds_cptr)lds, qr, 0xfu, att::MkNoBias{}, lane);
                const float ltot = st.l + __shfl_xor(st.l, 32);
                att::store_rows<128>(st, ltot, OCAT + trow * 1536 + 1024 + mh * 128, true, hi); }
            ATT_WAIT_BAR();
        }
    }
    SEAM(2);
    if (IN(3)) { PR_BEGIN(5);
        const unsigned lds0 = (unsigned)(uintptr_t)lds; const int r32 = lane & 31, hi = lane >> 5;
        LAS unsigned short* pre = (LAS unsigned short*)(lds + att::L_PRE);
        LAS unsigned short* lcs = (LAS unsigned short*)(lds + att::L_LC);
        for (int i = tid; i < 2048; i += NWAVES * 64) { const int h = i >> 8, d = (i & 255) - 64; ((LAS float*)(lds + att::L_TAB))[i] = d < 0 ? -INFINITY : (d < 128 ? tab[h * 128 + d] - tab[h * 128 + 127] : 0.f); }
        if (tid < 64) {
            unsigned v[16], s = 0;
#pragma unroll
            for (int j = 0; j < 16; ++j) { const unsigned L = LCNT[tid * 16 + j]; lcs[tid * 16 + j] = (unsigned short)L; v[j] = 1u + (L + 255u) / 256u; s += v[j]; }
            unsigned inc = s;
#pragma unroll
            for (int o = 1; o < 64; o <<= 1) { const unsigned t = __shfl_up(inc, o); if (tid >= o) inc += t; }
            unsigned run = inc - s;
#pragma unroll
            for (int j = 0; j < 16; ++j) { pre[tid * 16 + j] = (unsigned short)run; run += v[j]; }
            if (tid == 63) pre[1024] = (unsigned short)run;
        }
        __syncthreads();
        const int U = pre[1024];
#define P3_DECODE(u_, bh_, n_, j_) do { int lo_ = 0, hi_ = 1024; while (hi_ - lo_ > 1) { const int mid_ = (lo_ + hi_) >> 1; if ((int)pre[mid_] <= (u_)) lo_ = mid_; else hi_ = mid_; } \
            bh_ = lo_ >> 5; n_ = lo_ & 31; j_ = (u_) - (int)pre[lo_]; } while (0)
#define P3_KV(base_, bh_, n_) ((base_) + ((size_t)(bh_) * (SEQ / 64) + (n_) * 4) * 4096)
#define P3_ENTRY(bh_, n_, j_, e_, ok_) do { e_ = 0u; ok_ = true; if ((j_) > 0) { const unsigned p_ = (unsigned)(256 * ((j_) - 1) + 32 * wid + r32); ok_ = p_ < (unsigned)lcs[(bh_) * NBLK + (n_)]; \
            if (ok_) e_ = LIST[(size_t)(bh_) * LIST_BH + 256 * (31 * (n_) - ((n_) * ((n_) - 1)) / 2) + p_]; } } while (0)
#define P3_SPOS(e_, n_) (((e_) == 0xffffffffu) ? (n_) * MBLK : (((e_) & 0x20000u) ? (n_) * MBLK + (int)((e_) & 255u) : (int)(((e_) >> 10) & 31u) * MBLK + (int)((e_) & 255u)))
#define P3_RANK(e_) (((e_) & 0x20000u) ? 3 : (int)(((e_) >> 8) & 3u))
        int g = (int)(((long)U * bx) / G); const int g_hi = (int)(((long)U * (bx + 1)) / G);
        int bi = 0, bi1 = 0, cs = 0; unsigned e = 0, e1 = 0; bf16x8 qr[4];
#define P3_DESC(bi_, g_, e_) do { const int bh_ = (bi_) >> 5, n_ = (bi_) & 31, j_ = (g_) - (int)pre[bi_]; bool ok_; P3_ENTRY(bh_, n_, j_, e_, ok_); if (j_ == 0) e_ = 0x30000u | (unsigned)(32 * wid + r32); else if (!ok_) e_ = 0xffffffffu; } while (0)
#define P3_QROW(bi_, e_) (PROJ + ((size_t)((bi_) >> 8) * SEQ + P3_SPOS(e_, (bi_) & 31)) * PJW + C_QMB + (((bi_) >> 5) & 7) * 64)
        if (g < g_hi) { int bh, n, j; P3_DECODE(g, bh, n, j); bi = bh * NBLK + n;
            att::stage_block<64>(lds0, 0, P3_KV(KMB, bh, n), P3_KV(VMB, bh, n), 0xfu, wid, lane);
            P3_DESC(bi, g, e); att::load_q<64>(qr, P3_QROW(bi, e), hi);
            bi1 = bi; if (g + 1 < g_hi) { if (g + 1 >= (int)pre[bi + 1]) bi1 = bi + 1; P3_DESC(bi1, g + 1, e1); } }
        bool fresh = true;
        for (; g < g_hi; ++g) {
            const int bh = bi >> 5, n = bi & 31, j = g - (int)pre[bi];
            if (fresh) { PR_BEGIN(1); ATT_WAIT_BAR(); PR_END(1);
                if ((int)pre[bi + 1] < g_hi) { const int b2 = (bi + 1) >> 5, n2 = (bi + 1) & 31;
                    att::stage_block<64>(lds0, (cs ^ 1) * att::SET_BYTES, P3_KV(KMB, b2, n2), P3_KV(VMB, b2, n2), 0xfu, wid, lane); } }
            PR_BEGIN(3);
            bf16x8 qn[4]; unsigned e2 = 0; int bi2 = bi1;
            if (g + 1 < g_hi) att::load_q<64>(qn, P3_QROW(bi1, e1), hi);
            if (g + 2 < g_hi) { if (g + 2 >= (int)pre[bi1 + 1]) bi2 = bi1 + 1; P3_DESC(bi2, g + 2, e2); }
            PR_END(3);
            { const int b = bh >> 3, h = bh & 7; const int spos = P3_SPOS(e, n);
              att::State<64> st; att::init_state<64>(st, 0.f, 0.f);
              att::MkCInit<false> mk{(const LAS float*)(lds + att::L_TAB) + h * 256 + 64, spos - n * MBLK, hi};
              PR_BEGIN(2); att::block64<true>(st.o, st.m, st.l, (att::lds_cptr)lds + cs * att::SET_BYTES, qr, 0, (j == 0) ? (wid >> 1) : 3, mk, lane); PR_END(2);
              PR_BEGIN(4);
              const float ltot = st.l + __shfl_xor(st.l, 32);
              const int rank = P3_RANK(e); const bool valid = e != 0xffffffffu; const size_t trow = (size_t)b * SEQ + P3_SPOS(e, n);
              bf16_t* orow = (rank == 3) ? OCAT + trow * 1536 + h * 64 : (rank == 2 ? PO2 : PO01 + (size_t)rank * T * 512) + (trow * 8 + h) * 64;
              att::store_rows<64>(st, ltot, orow, valid, hi);
              if (valid && hi == 0) PL[((size_t)rank * T + trow) * 8 + h] = st.m + log2f(ltot); }
            fresh = bi1 != bi; if (fresh) cs ^= 1; bi = bi1; bi1 = bi2; e = e1; e1 = e2;
#pragma unroll
            for (int d0 = 0; d0 < 4; ++d0) qr[d0] = qn[d0];
            PR_END(4);
        }
        ATT_WAIT_BAR(); PR_END(5);
#undef P3_DECODE
#undef P3_KV
#undef P3_ENTRY
#undef P3_DESC
#undef P3_QROW
#undef P3_SPOS
#undef P3_RANK
    }
    SEAM(3);
    if (IN(4)) {
        for (int i = gt; i < T * 8 * 8; i += NGT) { const int ch = i & 7, h = (i >> 3) & 7, t = i >> 6; const int c = (t % SEQ) / MBLK, nsel = c < 3 ? c : 3;
            const size_t th = (size_t)t * 8 + h;
            float ls[4]; ls[3] = PL[(size_t)3 * T * 8 + th]; float M = ls[3];
#pragma unroll
            for (int r = 0; r < 3; ++r) { ls[r] = (r < nsel) ? PL[(size_t)r * T * 8 + th] : -INFINITY; M = fmaxf(M, ls[r]); }
            float wsum = 0.f, acc[8] = {0.f, 0.f, 0.f, 0.f, 0.f, 0.f, 0.f, 0.f};
#pragma unroll
            for (int r = 0; r < 4; ++r) { if (r < 3 && r >= nsel) continue; const float w = fast_exp2(ls[r] - M); wsum += w;
                const bf16_t* src = (r == 3) ? OCAT + (size_t)t * 1536 + h * 64 + ch * 8 : (r == 2 ? PO2 : PO01 + (size_t)r * T * 512) + th * 64 + ch * 8;
                const u32x4 v = *(const u32x4*)src;
#pragma unroll
                for (int e = 0; e < 4; ++e) { acc[2 * e] += w * __builtin_bit_cast(float, v[e] << 16); acc[2 * e + 1] += w * __builtin_bit_cast(float, v[e] & 0xffff0000u); } }
            const float inv = 1.0f / wsum; u32x4 o;
#pragma unroll
            for (int e = 0; e < 4; ++e) o[e] = cvt_pk_bf16(acc[2 * e] * inv, acc[2 * e + 1] * inv);
            *(u32x4*)(OCAT + (size_t)t * 1536 + h * 64 + ch * 8) = o; }
    }
    SEAM(4);
    if (IN(5)) { pg8::Gemm g{OCAT, Wbr_t, 1536, 1536, 512}; pg8::SubOrder3 S; S.init(T, D, G, bx); pg8::EpiBranch E{PROJ, MERGED}; pg8::gemm_phase(lds, g, S, E, pr_acc, 5); }
    SEAM(5);
    if (IN(6)) { pg8::Gemm g{MERGED, Wout_t, D, D, D}; pg8::StaticOrder S; S.init(T, D, G, bx); pg8::EpiBf16 E{Y1, D}; pg8::gemm_phase(lds, g, S, E, pr_acc, 6); }
    SEAM(6);
    if (IN(7)) {
        for (int row = gw; row < T; row += NGW) {
            const u32x2* yr = (const u32x2*)(Y1 + (size_t)row * D) + lane; const f32x4* xr = (const f32x4*)(x + (size_t)row * D) + lane;
            f32x4 v[4]; float s = 0.f;
#pragma unroll
            for (int j = 0; j < 4; ++j) { const u32x2 yw = yr[64 * j]; v[j] = (f32x4){__builtin_bit_cast(float, yw.x << 16), __builtin_bit_cast(float, yw.x & 0xffff0000u), __builtin_bit_cast(float, yw.y << 16), __builtin_bit_cast(float, yw.y & 0xffff0000u)}; s += v[j].x * v[j].x + v[j].y * v[j].y + v[j].z * v[j].z + v[j].w * v[j].w; }
            const float r = rsqrtf(wave_sum(s) * (1.0f / D) + RMS_EPS); float s2 = 0.f;
#pragma unroll
            for (int j = 0; j < 4; ++j) { const f32x4 gg = ((const f32x4*)g_mix_post)[lane + 64 * j]; v[j] = xr[64 * j] + v[j] * r * gg; s2 += v[j].x * v[j].x + v[j].y * v[j].y + v[j].z * v[j].z + v[j].w * v[j].w;
                ((f32x4*)(X1 + (size_t)row * D))[lane + 64 * j] = v[j]; }
            const float r2 = rsqrtf(wave_sum(s2) * (1.0f / D) + RMS_EPS);
#pragma unroll
            for (int j = 0; j < 4; ++j) { const f32x4 gg = ((const f32x4*)g_ffn_pre)[lane + 64 * j]; ((unsigned long long*)(H2 + (size_t)row * D))[lane + 64 * j] = pack4bf(v[j].x * r2 * gg.x, v[j].y * r2 * gg.y, v[j].z * r2 * gg.z, v[j].w * r2 * gg.w); }
        }
    }
    SEAM(7);
    if (IN(8)) { pg8::Gemm g{H2, Wup_t, D, D, D}; pg8::StaticOrder S; S.init(T, UPW, G, bx); pg8::EpiUp E{ACT, EDGE, convp}; pg8::gemm_phase(lds, g, S, E, pr_acc, 8); }
#if REP8 == 2
    if (IN(8)) { xcd_barrier(bar); pg8::Gemm g{H2, Wup_t, D, D, D}; pg8::StaticOrder S; S.init(T, UPW, G, bx); pg8::EpiUp E{ACT, EDGE, convp}; pg8::gemm_phase(lds, g, S, E, pr_acc, 8); }
#endif
    SEAM(8);
    if (IN(9)) {
        for (int i = gt; i < (T / 64) * 2 * (FF / 8); i += NGT) { const int c8 = i % (FF / 8), e = (i / (FF / 8)) & 1, g64 = i / (2 * (FF / 8));
            const int ch0 = c8 * 8, tcol = 256 * (ch0 >> 7) + (ch0 & 127); const bool first = (g64 % (SEQ / 64)) == 0;
            const bf16_t* cur = EDGE + ((size_t)g64 * 4 + e) * UPW + tcol;
            const bf16_t* p1 = (e == 1) ? EDGE + ((size_t)g64 * 4 + 0) * UPW + tcol : EDGE + ((size_t)(g64 - 1) * 4 + 3) * UPW + tcol;
            const bf16_t* p2 = (e == 1) ? EDGE + ((size_t)(g64 - 1) * 4 + 3) * UPW + tcol : EDGE + ((size_t)(g64 - 1) * 4 + 2) * UPW + tcol;
            const bool z1 = first && e == 0, z2 = first;
            u32x4 o;
#pragma unroll
            for (int hv = 0; hv < 2; ++hv) {
                float ug[4], uv[4];
#pragma unroll
                for (int gv = 0; gv < 2; ++gv) { const int off = gv * 128 + hv * 4; const float* cp = convp + tcol + off;
                    const f32x4 w0 = *(const f32x4*)cp, w1 = *(const f32x4*)(cp + UPW), w2 = *(const f32x4*)(cp + 2 * UPW), wb = *(const f32x4*)(cp + 3 * UPW);
                    const u32x2 c = *(const u32x2*)(cur + off); u32x2 a = {0u, 0u}, bb = {0u, 0u}; if (!z1) a = *(const u32x2*)(p1 + off); if (!z2) bb = *(const u32x2*)(p2 + off);
#pragma unroll
                    for (int k = 0; k < 4; ++k) { const unsigned cw = c[k >> 1], aw = a[k >> 1], bw = bb[k >> 1];
                        const float fc = __builtin_bit_cast(float, (k & 1) ? (cw & 0xffff0000u) : (cw << 16)), fa = __builtin_bit_cast(float, (k & 1) ? (aw & 0xffff0000u) : (aw << 16)), fb = __builtin_bit_cast(float, (k & 1) ? (bw & 0xffff0000u) : (bw << 16));
                        const float uu = wb[k] + w2[k] * fc + w1[k] * fa + w0[k] * fb; if (gv == 0) ug[k] = uu; else uv[k] = uu; } }
                o[2 * hv] = cvt_pk_bf16(fast_gelu(ug[0]) * uv[0], fast_gelu(ug[1]) * uv[1]); o[2 * hv + 1] = cvt_pk_bf16(fast_gelu(ug[2]) * uv[2], fast_gelu(ug[3]) * uv[3]); }
            *(u32x4*)(ACT + (size_t)(g64 * 64 + e) * FF + ch0) = o; }
    }
    SEAM(9);
    if (IN(10)) { pg8::Gemm g{ACT, Wdown_t, FF, FF, FF}; pg8::StaticOrder S; S.init(T, D, G, bx); pg8::EpiBf16 E{Y2, D}; pg8::gemm_phase(lds, g, S, E, pr_acc, 10); }
    SEAM(10);
    if (IN(11)) {
        const bool poison = __hip_atomic_load((unsigned*)(ctl + CW_BAR) + args.li * XCD_BAR_WORDS + XB_TMO, __ATOMIC_RELAXED, __HIP_MEMORY_SCOPE_AGENT) != 0u;
        for (int row = gw; row < T; row += NGW) {
            const u32x2* yr = (const u32x2*)(Y2 + (size_t)row * D) + lane; f32x4* xr = (f32x4*)(out + (size_t)row * D) + lane;
            f32x4 v[4]; float s = 0.f;
#pragma unroll
            for (int j = 0; j < 4; ++j) { const u32x2 yw = yr[64 * j]; v[j] = (f32x4){__builtin_bit_cast(float, yw.x << 16), __builtin_bit_cast(float, yw.x & 0xffff0000u), __builtin_bit_cast(float, yw.y << 16), __builtin_bit_cast(float, yw.y & 0xffff0000u)}; s += v[j].x * v[j].x + v[j].y * v[j].y + v[j].z * v[j].z + v[j].w * v[j].w; }
            float r = rsqrtf(wave_sum(s) * (1.0f / D) + RMS_EPS); if (poison) r = __builtin_nanf("");
#pragma unroll
            for (int j = 0; j < 4; ++j) { const f32x4 gg = ((const f32x4*)g_ffn_post)[lane + 64 * j]; xr[64 * j] = xr[64 * j] + v[j] * r * gg; }
        }
    }
#ifdef PROBE_REGION
#ifndef PROBE_TID
#define PROBE_TID 0
#endif
    if (tid == PROBE_TID) { atomicMax(&ctl[8], (unsigned)pr_acc); atomicMax(&ctl[9], 0xffffffffu - (unsigned)pr_acc); }
    xcd_barrier(bar);
    if (bx == 0 && tid == 0) { unsigned long long w = pr_acc; if (PROBE_STAT == 1) w = __hip_atomic_load(&ctl[8], __ATOMIC_RELAXED, __HIP_MEMORY_SCOPE_AGENT); if (PROBE_STAT == 2) w = 0xffffffffu - __hip_atomic_load(&ctl[9], __ATOMIC_RELAXED, __HIP_MEMORY_SCOPE_AGENT);
        const unsigned long long te = __builtin_amdgcn_s_memrealtime(); while (__builtin_amdgcn_s_memrealtime() - te < w) __builtin_amdgcn_s_sleep(8); }
#endif
#ifdef PROBE_LO
    STAMP(12);
    if (bx == 0 && tid == 0) {
        const unsigned long long t0 = ((unsigned long long)MISC[17 + 2 * PROBE_LO] << 32) | MISC[16 + 2 * PROBE_LO], t1 = ((unsigned long long)MISC[17 + 2 * PROBE_HI] << 32) | MISC[16 + 2 * PROBE_HI];
        const unsigned long long te = __builtin_amdgcn_s_memrealtime(); while (__builtin_amdgcn_s_memrealtime() - te < (t1 - t0)) __builtin_amdgcn_s_sleep(8); }
#endif
#undef IN
#undef SEAM
}
extern "C" void kernel_launch(void* const* d_in, const int* in_sizes, int n_in, void* d_out, int out_size, void* d_ws, size_t ws_size, hipStream_t stream) {
    if (n_in != 19 || in_sizes[0] != T * D || out_size != T * D || ws_size < WS_END) { fprintf(stderr, "kernel_launch: unexpected shapes / workspace (n_in %d, ws %zu)\n", n_in, ws_size); return; }
    static int grid = 0;
    if (grid == 0) {
        int dev = 0, cus = 0, per_cu = 0;
        if (hipGetDevice(&dev) != hipSuccess || hipDeviceGetAttribute(&cus, hipDeviceAttributeMultiprocessorCount, dev) != hipSuccess) { fprintf(stderr, "kernel_launch: device query failed\n"); grid = -1; return; }
        if (hipFuncSetAttribute((const void*)mega_fwd, hipFuncAttributeMaxDynamicSharedMemorySize, LDS_BYTES) != hipSuccess) { fprintf(stderr, "kernel_launch: hipFuncSetAttribute failed\n"); grid = -1; return; }
        if (hipOccupancyMaxActiveBlocksPerMultiprocessor(&per_cu, (const void*)mega_fwd, NWAVES * 64, LDS_BYTES) != hipSuccess || per_cu < 1) { fprintf(stderr, "kernel_launch: occupancy query says %d blocks per CU\n", per_cu); (void)hipGetLastError(); grid = -1; return; }
        grid = cus;
    }
    if (grid < 0) return;
    (void)hipMemsetAsync((unsigned char*)d_ws + WS_CTL, 0, CTL_ZERO_BYTES, stream);
    Args a{}; for (int i = 0; i < 19; ++i) a.in[i] = (const float*)d_in[i]; a.out = (float*)d_out; a.ws = (unsigned char*)d_ws; a.ph_lo = 0; a.ph_hi = NPHASE; a.li = 0; a.pad = 0;
    hipLaunchKernelGGL(mega_fwd, dim3(grid), dim3(NWAVES * 64), LDS_BYTES, stream, a);
}
```
